# Optimizing an MI355X kernel written in HIP

```python
import jax, jax.numpy as jnp
from jax import lax
import numpy as np

D_MODEL = 4096
BATCH = 4
SEQ = 2048
DEPTH = 1
DEC_BATCH = 128
DEC_SEQ = 1
PAST_LEN = 16384
PAGE_SIZE = 128

D_CONV = D_MODEL // 2
CONV_W = 3
GLA_HEADS = 8
GLA_DK = 256
GLA_DV = 256
GLA_KEY = GLA_HEADS * GLA_DK
GLA_VAL = GLA_HEADS * GLA_DV
GATE_RANK = 16
GATE_NORM = 16.0
GLA_CHUNK = 32
D_FF = 11008
PLE_DIM = 256
EPS = 1e-6

kernel_name = 'hybrid_shortconv_gla_convffn_step'


def _split_sizes():
    return [D_CONV, D_CONV, D_CONV, GLA_KEY, GLA_KEY, GLA_VAL, GLA_VAL, GATE_RANK, D_MODEL, D_MODEL]


def _rmsnorm(x, g):
    xf = x.astype(jnp.float32)
    y = xf * lax.rsqrt(jnp.mean(xf * xf, axis=-1, keepdims=True) + EPS)
    return (y * g.astype(jnp.float32)).astype(x.dtype)


def _causal_conv(u, buf, w):
    T = u.shape[1]
    up = jnp.concatenate([buf.astype(u.dtype), u], axis=1)
    out = w[0] * up[:, 0:T]
    for j in range(1, CONV_W):
        out = out + w[j] * up[:, j:j + T]
    return out, up[:, -(CONV_W - 1):]


def _gla(q, k, v, log_a, S0):
    Bsz, T, H, DK = q.shape
    DV = v.shape[-1]
    C = GLA_CHUNK
    nC = -(-T // C)
    pad = nC * C - T
    f32 = jnp.float32
    q, k, v, log_a = (t.astype(f32) for t in (q, k, v, log_a))
    if pad:
        pw = ((0, 0), (0, pad), (0, 0), (0, 0))
        q, k, v, log_a = (jnp.pad(t, pw) for t in (q, k, v, log_a))
    q = q.reshape(Bsz, nC, C, H, DK)
    k = k.reshape(Bsz, nC, C, H, DK)
    v = v.reshape(Bsz, nC, C, H, DV)
    b = jnp.cumsum(log_a.reshape(Bsz, nC, C, H, DK), axis=2)
    b_last = b[:, :, -1:]
    q_t = q * jnp.exp(b)
    k_t = k * jnp.exp(-b)
    k_s = k * jnp.exp(b_last - b)
    mask = jnp.tril(jnp.ones((C, C), dtype=bool))
    scores = jnp.einsum('bnthk,bnshk->bnhts', q_t, k_t)
    scores = jnp.where(mask, scores, 0.0)
    o_intra = jnp.einsum('bnhts,bnshv->bnthv', scores, v)
    decay = jnp.exp(b_last[:, :, 0])

    def step(S, inp):
        qc, kc, vc, dc = inp
        o = jnp.einsum('bthk,bhkv->bthv', qc, S)
        S = S * dc[..., None] + jnp.einsum('bthk,bthv->bhkv', kc, vc)
        return S, o

    xs = (jnp.moveaxis(q_t, 1, 0), jnp.moveaxis(k_s, 1, 0), jnp.moveaxis(v, 1, 0), jnp.moveaxis(decay, 1, 0))
    S_fin, o_inter = lax.scan(step, S0.astype(f32), xs)
    o = o_intra + jnp.moveaxis(o_inter, 0, 1)
    o = o.reshape(Bsz, nC * C, H, DV)[:, :T]
    return o, S_fin


def _layer(h, p_i, conv_buf, gla_S, ffn_buf, lw):
    (g_mix, w_in, w_alpha2, b_alpha, w_conv, w_out_conv, g_gla, w_out_gla, w_mix_out,
     g_ffn, w_up, w_ffn_conv, w_down, g_ple, w_ple_gate, w_ple_proj) = lw
    Bsz, T, _ = h.shape
    n = _rmsnorm(h, g_mix)
    z = n @ w_in
    idx = [int(s) for s in np.cumsum(_split_sizes())[:-1]]
    hA, cA, bA, q, k, v, r, a_lr, gate_a, gate_b = jnp.split(z, idx, axis=-1)
    cu, conv_new = _causal_conv(cA * hA, conv_buf, w_conv)
    yA = (bA * cu) @ w_out_conv
    log_a = jax.nn.log_sigmoid((a_lr @ w_alpha2 + b_alpha).astype(jnp.float32)) / GATE_NORM
    q = q.reshape(Bsz, T, GLA_HEADS, GLA_DK) * (GLA_DK ** -0.5)
    k = k.reshape(Bsz, T, GLA_HEADS, GLA_DK)
    v = v.reshape(Bsz, T, GLA_HEADS, GLA_DV)
    log_a = log_a.reshape(Bsz, T, GLA_HEADS, GLA_DK)
    o, S_new = _gla(q, k, v, log_a, gla_S)
    o = _rmsnorm(o.astype(h.dtype), g_gla).reshape(Bsz, T, GLA_VAL)
    yB = (o * jax.nn.silu(r)) @ w_out_gla
    merged = jax.nn.sigmoid(gate_a) * yA + jax.nn.sigmoid(gate_b) * yB
    h = h + merged @ w_mix_out
    up, ffn_new = _causal_conv(_rmsnorm(h, g_ffn) @ w_up, ffn_buf, w_ffn_conv)
    fg, fv = jnp.split(up, 2, axis=-1)
    h = h + (jax.nn.silu(fg) * fv) @ w_down
    h = h + jax.nn.sigmoid(_rmsnorm(h, g_ple) @ w_ple_gate) * (p_i @ w_ple_proj)
    return h, conv_new.astype(conv_buf.dtype), S_new.astype(gla_S.dtype), ffn_new.astype(ffn_buf.dtype)


def _trunk(x, p, conv_states, gla_states, ffn_states, weights, g_final):
    h = x
    convs, glas, ffns = [], [], []
    for i in range(DEPTH):
        lw = tuple(w[i] for w in weights)
        h, c_new, s_new, f_new = _layer(h, p[i], conv_states[i], gla_states[i], ffn_states[i], lw)
        convs.append(c_new)
        glas.append(s_new)
        ffns.append(f_new)
    return _rmsnorm(h, g_final), jnp.stack(convs), jnp.stack(glas), jnp.stack(ffns)


def setup_inputs(seed: int = 0) -> dict:
    key = jax.random.key(seed)
    ks = jax.random.split(key, 32)
    nrm = jax.random.normal
    f32 = jnp.float32
    d_in = sum(_split_sizes())

    def w(k, shape, fan_in):
        return nrm(k, shape, f32) * (fan_in ** -0.5)

    def gain(k, shape):
        return 1.0 + 0.01 * nrm(k, shape, f32)

    return {
        'x_prompt': nrm(ks[0], (BATCH, SEQ, D_MODEL), f32),
        'x_sample': nrm(ks[1], (DEC_BATCH, DEC_SEQ, D_MODEL), f32),
        'p_prompt': nrm(ks[2], (DEPTH, BATCH, SEQ, PLE_DIM), f32),
        'p_sample': nrm(ks[3], (DEPTH, DEC_BATCH, DEC_SEQ, PLE_DIM), f32),
        'state_conv': nrm(ks[4], (DEPTH, DEC_BATCH, CONV_W - 1, D_CONV), f32),
        'state_gla': 0.5 * nrm(ks[5], (DEPTH, DEC_BATCH, GLA_HEADS, GLA_DK, GLA_DV), f32),
        'state_ffn': nrm(ks[6], (DEPTH, DEC_BATCH, CONV_W - 1, 2 * D_FF), f32),
        'g_mix': gain(ks[7], (DEPTH, D_MODEL)),
        'w_in': w(ks[8], (DEPTH, D_MODEL, d_in), D_MODEL),
        'w_alpha2': w(ks[9], (DEPTH, GATE_RANK, GLA_KEY), GATE_RANK),
        'b_alpha': 0.01 * nrm(ks[10], (DEPTH, GLA_KEY), f32),
        'w_conv': w(ks[11], (DEPTH, CONV_W, D_CONV), CONV_W),
        'w_out_conv': w(ks[12], (DEPTH, D_CONV, D_MODEL), D_CONV),
        'g_gla': gain(ks[13], (DEPTH, GLA_DV)),
        'w_out_gla': w(ks[14], (DEPTH, GLA_VAL, D_MODEL), GLA_VAL),
        'w_mix_out': w(ks[15], (DEPTH, D_MODEL, D_MODEL), D_MODEL),
        'g_ffn': gain(ks[16], (DEPTH, D_MODEL)),
        'w_up': w(ks[17], (DEPTH, D_MODEL, 2 * D_FF), D_MODEL),
        'w_ffn_conv': w(ks[18], (DEPTH, CONV_W, 2 * D_FF), CONV_W),
        'w_down': w(ks[19], (DEPTH, D_FF, D_MODEL), D_FF),
        'g_ple': gain(ks[20], (DEPTH, D_MODEL)),
        'w_ple_gate': w(ks[21], (DEPTH, D_MODEL, D_MODEL), D_MODEL),
        'w_ple_proj': w(ks[22], (DEPTH, PLE_DIM, D_MODEL), PLE_DIM),
        'g_final': gain(ks[23], (D_MODEL,)),
    }


def reference(x_prompt, x_sample, p_prompt, p_sample, state_conv, state_gla, state_ffn,
              g_mix, w_in, w_alpha2, b_alpha, w_conv, w_out_conv, g_gla, w_out_gla, w_mix_out,
              g_ffn, w_up, w_ffn_conv, w_down, g_ple, w_ple_gate, w_ple_proj, g_final):
    weights = (g_mix, w_in, w_alpha2, b_alpha, w_conv, w_out_conv, g_gla, w_out_gla, w_mix_out,
               g_ffn, w_up, w_ffn_conv, w_down, g_ple, w_ple_gate, w_ple_proj)
    Bp = x_prompt.shape[0]
    dt = x_prompt.dtype
    conv0 = jnp.zeros((DEPTH, Bp, CONV_W - 1, D_CONV), dt)
    gla0 = jnp.zeros((DEPTH, Bp, GLA_HEADS, GLA_DK, GLA_DV), dt)
    ffn0 = jnp.zeros((DEPTH, Bp, CONV_W - 1, 2 * D_FF), dt)
    y_prompt, conv_p, gla_p, ffn_p = _trunk(x_prompt, p_prompt, conv0, gla0, ffn0, weights, g_final)
    y_sample, conv_s, gla_s, ffn_s = _trunk(x_sample, p_sample, state_conv, state_gla, state_ffn, weights, g_final)
    return (y_prompt, y_sample, conv_p, conv_s, gla_p, gla_s, ffn_p, ffn_s)
```

```cpp
#include <hip/hip_runtime.h>
#include <cstdio>
#include <cstdint>
namespace pg8 {
#define PG8_LAS __attribute__((address_space(3)))
typedef unsigned short bf16_t;
typedef short bf16x8 __attribute__((ext_vector_type(8)));
typedef float f32x4 __attribute__((ext_vector_type(4)));
typedef unsigned u32x4 __attribute__((ext_vector_type(4)));
constexpr int BM = 256, BK = 64, HALF = 128, HTB = HALF * BK * 2  , STAGE_BYTES = 8 * HTB, NXCD = 8, WGM = 4;

__host__ __device__ __forceinline__ int lds_byte(int r, int c) { const int st = (r >> 4) * 2 + (c >> 5), rr = r & 15, cc = c & 31, ob = rr * 64 + cc * 2; return st * 1024 + (ob ^ (((ob >> 9) & 1) << 5)); }
__host__ __device__ __forceinline__ void stage_rc(int b, int& R, int& C) { const int st = b / 1024, sb = b % 1024, swz = sb ^ (((sb >> 9) & 1) << 5); R = (st >> 1) * 16 + swz / 64; C = (st & 1) * 32 + (swz % 64) / 2; }
__host__ __device__ __forceinline__ int perm32(int rho) { const int n = rho >> 4, i = rho & 15; return 8 * (i >> 2) + 4 * n + (i & 3); }

struct Unit { int pm, pn, am, kb; };
struct Gemm { const bf16_t* A; const bf16_t* Bt; int M, N, K, ld; };

struct StaticOrder {
    int nM, nN, nwg, G, c;
    __host__ __device__ void init(int M, int N, int G_, int c_) { nM = M / BM; nN = N / BM; nwg = nM * nN; G = G_; c = c_; }
    __host__ __device__ bool next(int i, Unit& u) const {
        const long L = (long)i * G + c; if (L >= nwg) return false;
        int wgid = (int)L; { const int q = nwg / NXCD, r = nwg % NXCD, xcd = wgid % NXCD, off = wgid / NXCD; wgid = (xcd < r ? xcd * (q + 1) : r * (q + 1) + (xcd - r) * q) + off; }
        const int nig = WGM * nN, gid = wgid / nig, fm = gid * WGM, gsz = (nM - fm) < WGM ? (nM - fm) : WGM;
        u.pm = fm + ((wgid % nig) % gsz); u.pn = (wgid % nig) / gsz; u.am = u.pm; u.kb = 0; return true;
    }
    __device__ __forceinline__ void a_ready(const Unit&) const {}
    __device__ __forceinline__ void done(const Unit&) const {}
};

typedef __bf16 bf2_t __attribute__((ext_vector_type(2)));
typedef float f2_t __attribute__((ext_vector_type(2)));
__device__ __forceinline__ unsigned pk2(float lo, float hi) { f2_t v = {lo, hi}; bf2_t r = __builtin_convertvector(v, bf2_t); return __builtin_bit_cast(unsigned, r); }
__device__ __forceinline__ float bflo(unsigned w) { return __uint_as_float(w << 16); }
__device__ __forceinline__ float bfhi(unsigned w) { return __uint_as_float(w & 0xffff0000u); }
__device__ __forceinline__ u32x4 pk8(const f32x4& a, const f32x4& b) { u32x4 w; w.x = pk2(a[0], a[1]); w.y = pk2(a[2], a[3]); w.z = pk2(b[0], b[1]); w.w = pk2(b[2], b[3]); return w; }
__device__ __forceinline__ void unpk8(const u32x4& w, f32x4& a, f32x4& b) { a = (f32x4){bflo(w.x), bfhi(w.x), bflo(w.y), bfhi(w.y)}; b = (f32x4){bflo(w.z), bfhi(w.z), bflo(w.w), bfhi(w.w)}; }
__device__ __forceinline__ float sigm(float x) { return __builtin_amdgcn_rcpf(1.0f + __builtin_amdgcn_exp2f(-1.44269504089f * x)); }
__device__ __forceinline__ f32x4 sigm4(const f32x4& x) { return (f32x4){sigm(x[0]), sigm(x[1]), sigm(x[2]), sigm(x[3])}; }
typedef unsigned u32x2 __attribute__((ext_vector_type(2)));
typedef int i32x4_t __attribute__((ext_vector_type(4)));
typedef int i32x8_t __attribute__((ext_vector_type(8)));
__device__ __forceinline__ i32x8_t cat8(const bf16x8& lo, const bf16x8& hi) { const i32x4_t a = __builtin_bit_cast(i32x4_t, lo), b = __builtin_bit_cast(i32x4_t, hi); return __builtin_shufflevector(a, b, 0, 1, 2, 3, 4, 5, 6, 7); }
__device__ __forceinline__ unsigned pk4f8(float a, float b, float c, float d) { int w = 0; w = __builtin_amdgcn_cvt_pk_fp8_f32(a, b, w, false); w = __builtin_amdgcn_cvt_pk_fp8_f32(c, d, w, true); return (unsigned)w; }
constexpr int MROWS = 8320;

struct PanelOrder {
    int pm, n, c0, nc, c;
    __device__ __forceinline__ bool next(int i, Unit& u) const { const int L = i * nc + (c - c0); if (c < c0 || c >= c0 + nc || L >= n) return false; u.pm = pm; u.pn = L; u.am = pm; u.kb = 0; return true; }
    __device__ __forceinline__ void a_ready(const Unit&) const {}
    __device__ __forceinline__ void done(const Unit&) const {}
};
struct SplitOrder {
    int am, ntile, nsplit, s0, kbase, klen, c0, nc, c, deal;
    __device__ __forceinline__ bool next(int i, Unit& u) const {
        int L;
        if (deal == 0) { L = i * nc + (c - c0); if (c < c0 || c >= c0 + nc) return false; }
        else if (deal == 1) { if (c >= 192) { if (i >= 4) return false; L = (c - 192) + 64 * i; } else { if (i > 0) return false; L = 256 + c; } }
        else { if (c >= 192) { if (i >= 3) return false; L = (c - 192) + 64 * i; } else { if (i > 0) return false; L = 192 + c; } }
        if (L >= ntile * nsplit) return false;
        const int sl = L / ntile; u.pn = L - sl * ntile; u.pm = s0 + sl; u.am = am; u.kb = (kbase + sl * klen) * 2; return true; }
    __device__ __forceinline__ void a_ready(const Unit&) const {}
    __device__ __forceinline__ void done(const Unit&) const {}
};
struct SameOrder { int n; __device__ __forceinline__ bool next(int i, Unit& u) const { if (i >= n) return false; u.pm = 0; u.pn = 0; u.am = 0; u.kb = 0; return true; }
    __device__ __forceinline__ void a_ready(const Unit&) const {}
    __device__ __forceinline__ void done(const Unit&) const {} };
struct EpiBf {
    static constexpr bool PERM = true, AFTER_DRAIN = false;
    bf16_t* O; int ldc; const float* rs; int nai; const float* ssq4;
    __device__ __forceinline__ void operator()(const f32x4 (&acc)[2][2][4][2], const Unit& u, int wr, int wc, int fr, int fq) const {
        const int row0 = u.pm * BM + wr * 64 + fr, col0 = u.pn * BM + wc * 32 + 8 * fq;
#pragma unroll
        for (int ai = 0; ai < 2; ++ai)
#pragma unroll
            for (int m = 0; m < 4; ++m) { if (ai >= nai) continue; const int row = row0 + ai * HALF + m * 16; bf16_t* rowp = O + (size_t)row * ldc + col0; float s = rs ? rs[row] : 1.0f;
                if (ssq4) { const f32x4 q4 = *(const f32x4*)(ssq4 + 4 * (size_t)row); s = 1.0f / sqrtf(((q4[0] + q4[1]) + (q4[2] + q4[3])) * (1.0f / 4096.0f) + 1e-6f); }
#pragma unroll
                for (int bj = 0; bj < 2; ++bj) *(u32x4*)(rowp + bj * HALF) = pk8(acc[ai][bj][m][0] * s, acc[ai][bj][m][1] * s); }
    }
};
struct EpiF32 {
    static constexpr bool PERM = true, AFTER_DRAIN = false;
    float* C; int ldc; int nai; int rpm;
    __device__ __forceinline__ void operator()(const f32x4 (&acc)[2][2][4][2], const Unit& u, int wr, int wc, int fr, int fq) const {
        const int row0 = u.pm * rpm + wr * 64 + fr, col0 = u.pn * BM + wc * 32 + 8 * fq;
#pragma unroll
        for (int ai = 0; ai < 2; ++ai)
#pragma unroll
            for (int m = 0; m < 4; ++m) { if (ai >= nai) continue; float* rowp = C + (size_t)(row0 + ai * HALF + m * 16) * ldc + col0;
#pragma unroll
                for (int bj = 0; bj < 2; ++bj) { *(f32x4*)(rowp + bj * HALF) = acc[ai][bj][m][0]; *(f32x4*)(rowp + bj * HALF + 4) = acc[ai][bj][m][1]; } }
    }
};
struct EpiBfI8 {
    static constexpr bool PERM = true, AFTER_DRAIN = false;
    bf16_t* O; int ldc; const float* rs; const float* cs; int nai;
    __device__ __forceinline__ void operator()(const f32x4 (&acc)[2][2][4][2], const Unit& u, int wr, int wc, int fr, int fq) const {
        const int row0 = u.pm * BM + wr * 64 + fr, col0 = u.pn * BM + wc * 32 + 8 * fq;
        f32x4 c0[2], c1[2];
#pragma unroll
        for (int bj = 0; bj < 2; ++bj) { c0[bj] = *(const f32x4*)(cs + col0 + bj * HALF); c1[bj] = *(const f32x4*)(cs + col0 + bj * HALF + 4); }
        float sr[2][4];
#pragma unroll
        for (int ai = 0; ai < 2; ++ai)
#pragma unroll
            for (int m = 0; m < 4; ++m) sr[ai][m] = ai < nai ? rs[row0 + ai * HALF + m * 16] : 0.f;
#pragma unroll
        for (int ai = 0; ai < 2; ++ai)
#pragma unroll
            for (int m = 0; m < 4; ++m) { if (ai >= nai) continue; const int row = row0 + ai * HALF + m * 16; bf16_t* rowp = O + (size_t)row * ldc + col0; const float s = sr[ai][m];
#pragma unroll
                for (int bj = 0; bj < 2; ++bj) { const i32x4_t a0 = __builtin_bit_cast(i32x4_t, acc[ai][bj][m][0]), a1 = __builtin_bit_cast(i32x4_t, acc[ai][bj][m][1]);
                    const f32x4 sc0 = c0[bj] * s, sc1 = c1[bj] * s; const f32x4 f0 = (f32x4){(float)a0[0], (float)a0[1], (float)a0[2], (float)a0[3]} * sc0, f1 = (f32x4){(float)a1[0], (float)a1[1], (float)a1[2], (float)a1[3]} * sc1;
                    *(u32x4*)(rowp + bj * HALF) = pk8(f0, f1); } }
    }
};
struct EpiF32S {
    static constexpr bool PERM = true, AFTER_DRAIN = false;
    float* C; int ldc;
    __device__ __forceinline__ void operator()(const f32x4 (&acc)[2][2][4][2], const Unit& u, int wr, int wc, int fr, int fq) const {
        const int row0 = u.pm * 144 + wr * 64 + fr, col0 = u.pn * BM + wc * 32 + 8 * fq;
#pragma unroll
        for (int ai = 0; ai < 2; ++ai)
#pragma unroll
            for (int m = 0; m < 4; ++m) { if (ai == 1 && (m != 0 || wr != 0)) continue; float* rowp = C + (size_t)(row0 + ai * HALF + m * 16) * ldc + col0;
#pragma unroll
                for (int bj = 0; bj < 2; ++bj) { *(f32x4*)(rowp + bj * HALF) = acc[ai][bj][m][0]; *(f32x4*)(rowp + bj * HALF + 4) = acc[ai][bj][m][1]; } }
    }
};
struct EpiGate1 {
    static constexpr bool PERM = true, AFTER_DRAIN = false;
    const bf16_t* G; int ldg; bf16_t* O; int ldc; int nai;
    __device__ __forceinline__ void operator()(const f32x4 (&acc)[2][2][4][2], const Unit& u, int wr, int wc, int fr, int fq) const {
        const int row0 = u.pm * BM + wr * 64 + fr, col0 = u.pn * BM + wc * 32 + 8 * fq;
        u32x4 gw[2][4][2];
#pragma unroll
        for (int ai = 0; ai < 2; ++ai)
#pragma unroll
            for (int m = 0; m < 4; ++m) { if (ai >= nai) continue; const bf16_t* gp = G + (size_t)(row0 + ai * HALF + m * 16) * ldg + col0;
#pragma unroll
                for (int bj = 0; bj < 2; ++bj) gw[ai][m][bj] = *(const u32x4*)(gp + bj * HALF); }
#pragma unroll
        for (int ai = 0; ai < 2; ++ai)
#pragma unroll
            for (int m = 0; m < 4; ++m) { if (ai >= nai) continue; bf16_t* op = O + (size_t)(row0 + ai * HALF + m * 16) * ldc + col0;
#pragma unroll
                for (int bj = 0; bj < 2; ++bj) { f32x4 g0, g1; unpk8(gw[ai][m][bj], g0, g1);
                    *(u32x4*)(op + bj * HALF) = pk8(acc[ai][bj][m][0] * sigm4(g0), acc[ai][bj][m][1] * sigm4(g1)); } }
    }
};
struct EpiGate2 {
    static constexpr bool PERM = true, AFTER_DRAIN = false;
    const bf16_t* G; int ldg; bf16_t* O; int ldc; int nai; const float* rsq; const float* csq;
    __device__ __forceinline__ void operator()(const f32x4 (&acc)[2][2][4][2], const Unit& u, int wr, int wc, int fr, int fq) const {
        const int row0 = u.pm * BM + wr * 64 + fr, col0 = u.pn * BM + wc * 32 + 8 * fq;
#pragma unroll
        for (int ai = 0; ai < 2; ++ai) { if (ai >= nai) continue;
            u32x4 gw[4][2], tw[4][2];
#pragma unroll
            for (int m = 0; m < 4; ++m) { const int row = row0 + ai * HALF + m * 16; const bf16_t* gp = G + (size_t)row * ldg + col0; const bf16_t* op = O + (size_t)row * ldc + col0;
#pragma unroll
                for (int bj = 0; bj < 2; ++bj) { gw[m][bj] = *(const u32x4*)(gp + bj * HALF); tw[m][bj] = *(const u32x4*)(op + bj * HALF); } }
#pragma unroll
            for (int m = 0; m < 4; ++m) { bf16_t* op = O + (size_t)(row0 + ai * HALF + m * 16) * ldc + col0;
#pragma unroll
                for (int bj = 0; bj < 2; ++bj) { f32x4 g0, g1, t0, t1; unpk8(gw[m][bj], g0, g1); unpk8(tw[m][bj], t0, t1);
                    f32x4 a0 = acc[ai][bj][m][0], a1 = acc[ai][bj][m][1];
                    if (csq) { const i32x4_t i0 = __builtin_bit_cast(i32x4_t, a0), i1 = __builtin_bit_cast(i32x4_t, a1); const float sq = rsq[row0 + ai * HALF + m * 16];
                        a0 = (f32x4){(float)i0[0], (float)i0[1], (float)i0[2], (float)i0[3]} * (*(const f32x4*)(csq + col0 + bj * HALF) * sq); a1 = (f32x4){(float)i1[0], (float)i1[1], (float)i1[2], (float)i1[3]} * (*(const f32x4*)(csq + col0 + bj * HALF + 4) * sq); }
                    *(u32x4*)(op + bj * HALF) = pk8(t0 + a0 * sigm4(g0), t1 + a1 * sigm4(g1)); } }
            asm volatile("" ::: "memory"); }
    }
};
template <int SRC> struct EpiRes {
    static constexpr bool PERM = true, AFTER_DRAIN = false;
    const float* xp; const float* xs; float* out; bf16_t* XN; int ldx; float* part; int nai; unsigned char* h8; float* partm; const float* rsq; const float* csq;
    __device__ __forceinline__ void operator()(const f32x4 (&acc)[2][2][4][2], const Unit& u, int wr, int wc, int fr, int fq) const {
        const int row0 = u.pm * BM + wr * 64 + fr, col0 = u.pn * BM + wc * 32 + 8 * fq;
#pragma unroll
        for (int ai = 0; ai < 2; ++ai)
#pragma unroll
            for (int m = 0; m < 4; ++m) { if (ai >= nai) continue; const int row = row0 + ai * HALF + m * 16; const bool ok = row < MROWS;
                const float* hp = (row < 8192 ? xp + (size_t)row * 4096 : xs + (size_t)(row - 8192) * 4096) + col0;
                bf16_t* xn = XN + (size_t)row * ldx + col0; float ss = 0.f, am = 0.f;
#pragma unroll
                for (int bj = 0; bj < 2; ++bj) { f32x4 h0 = (f32x4){0.f, 0.f, 0.f, 0.f}, h1 = h0;
                    if (SRC == 0) { if (ok) { h0 = *(const f32x4*)(hp + bj * HALF); h1 = *(const f32x4*)(hp + bj * HALF + 4); } }
                    else { if (ok) { const u32x4 hw = *(const u32x4*)(xn + bj * HALF); unpk8(hw, h0, h1); } }
                    if (csq) { const i32x4_t i0 = __builtin_bit_cast(i32x4_t, acc[ai][bj][m][0]), i1 = __builtin_bit_cast(i32x4_t, acc[ai][bj][m][1]); const float sq = rsq[row];
                        const f32x4 c0 = *(const f32x4*)(csq + col0 + bj * HALF) * sq, c1 = *(const f32x4*)(csq + col0 + bj * HALF + 4) * sq;
                        h0 += (f32x4){(float)i0[0], (float)i0[1], (float)i0[2], (float)i0[3]} * c0; h1 += (f32x4){(float)i1[0], (float)i1[1], (float)i1[2], (float)i1[3]} * c1; }
                    else { h0 += acc[ai][bj][m][0]; h1 += acc[ai][bj][m][1]; }
                    ss += (h0[0] * h0[0] + h0[1] * h0[1]) + (h0[2] * h0[2] + h0[3] * h0[3]) + (h1[0] * h1[0] + h1[1] * h1[1]) + (h1[2] * h1[2] + h1[3] * h1[3]);
                    if (partm) am = fmaxf(am, fmaxf(fmaxf(fmaxf(fabsf(h0[0]), fabsf(h0[1])), fmaxf(fabsf(h0[2]), fabsf(h0[3]))), fmaxf(fmaxf(fabsf(h1[0]), fabsf(h1[1])), fmaxf(fabsf(h1[2]), fabsf(h1[3])))));
                    *(u32x4*)(xn + bj * HALF) = pk8(h0, h1);
                    }
                ss += __shfl_xor(ss, 16); ss += __shfl_xor(ss, 32);
                if (fq == 0) part[(size_t)row * 64 + u.pn * 4 + wc] = ss;
                if (partm) { am = fmaxf(am, __shfl_xor(am, 16)); am = fmaxf(am, __shfl_xor(am, 32)); if (fq == 0) partm[(size_t)row * 64 + u.pn * 4 + wc] = am; }
                if (SRC == 1 || (m & 1)) asm volatile("" ::: "memory"); }
    }
};
struct EpiPle {
    static constexpr bool PERM = true, AFTER_DRAIN = false;
    bf16_t* h3b; const bf16_t* pp; const float* rs; float* part; int nai; const bf16_t* XN; int ldx; const float* cs;
    __device__ __forceinline__ void operator()(const f32x4 (&acc)[2][2][4][2], const Unit& u, int wr, int wc, int fr, int fq) const {
        const int row0 = u.pm * BM + wr * 64 + fr, col0 = u.pn * BM + wc * 32 + 8 * fq;
        f32x4 c0[2], c1[2];
#pragma unroll
        for (int bj = 0; bj < 2; ++bj) { c0[bj] = (f32x4){1.f, 1.f, 1.f, 1.f}; c1[bj] = c0[bj]; if (cs) { c0[bj] = *(const f32x4*)(cs + col0 + bj * HALF); c1[bj] = *(const f32x4*)(cs + col0 + bj * HALF + 4); } }
#pragma unroll
        for (int ai = 0; ai < 2; ++ai)
#pragma unroll
            for (int m = 0; m < 4; ++m) { if (ai >= nai) continue; const int row = row0 + ai * HALF + m * 16; const bool ok = row < MROWS; const float s = rs[row];
                const bf16_t* pr = pp + (size_t)row * 4096 + col0; float ss = 0.f;
#pragma unroll
                for (int bj = 0; bj < 2; ++bj) { f32x4 h0 = (f32x4){0.f, 0.f, 0.f, 0.f}, h1 = h0;
                    if (ok) { const u32x4 hw = *(const u32x4*)(XN + (size_t)row * ldx + col0 + bj * HALF); unpk8(hw, h0, h1); }
                    f32x4 p0, p1; { const u32x4 pw = *(const u32x4*)(pr + bj * HALF); unpk8(pw, p0, p1); }
                    f32x4 a0 = acc[ai][bj][m][0], a1 = acc[ai][bj][m][1];
                    if (cs) { const i32x4_t i0 = __builtin_bit_cast(i32x4_t, a0), i1 = __builtin_bit_cast(i32x4_t, a1); a0 = (f32x4){(float)i0[0], (float)i0[1], (float)i0[2], (float)i0[3]} * c0[bj]; a1 = (f32x4){(float)i1[0], (float)i1[1], (float)i1[2], (float)i1[3]} * c1[bj]; }
                    h0 += sigm4(a0 * s) * p0; h1 += sigm4(a1 * s) * p1;
                    ss += (h0[0] * h0[0] + h0[1] * h0[1]) + (h0[2] * h0[2] + h0[3] * h0[3]) + (h1[0] * h1[0] + h1[1] * h1[1]) + (h1[2] * h1[2] + h1[3] * h1[3]);
                    if (ok) *(u32x4*)(h3b + (size_t)row * 4096 + col0 + bj * HALF) = pk8(h0, h1); }
                ss += __shfl_xor(ss, 16); ss += __shfl_xor(ss, 32);
                if (fq == 0) part[(size_t)row * 64 + u.pn * 4 + wc] = ss; }
    }
};
template <class Epi, class Sched, bool ALIGN_EPI = false, bool SP2 = false, bool HALF_M = false, bool F8 = false, bool I8 = false>
__device__ __forceinline__ void gemm_phase(PG8_LAS unsigned char* lds, const Gemm g, const Sched& S, const Epi& E) {
    int tid; asm volatile("v_mov_b32 %0, %1" : "=v"(tid) : "v"(threadIdx.x));
    const int wid = __builtin_amdgcn_readfirstlane(tid >> 6), lane = tid & 63, wr = wid >> 2, wc = wid & 3, fr = lane & 15, fq = lane >> 4;
    const int K = g.K, nt = K / BK, ld = g.ld;
    unsigned voffA[2], voffB[2];
#pragma unroll
    for (int i = 0; i < 2; ++i) { int R, C; stage_rc(tid * 16 + i * 8192, R, C); const int Rb = Epi::PERM ? ((R & ~31) + perm32(R & 31)) : R;
        voffA[i] = (unsigned)(R * ld + C) * 2u; voffB[i] = (unsigned)(Rb * ld + C) * 2u; }
    const size_t kstep = (size_t)(BK * 2);
    const size_t hstep = (size_t)HALF * ld * 2;
    const size_t tstep = 2 * hstep;
    const unsigned ldsw = (unsigned)wid * 1024u;
    const int aoff = lds_byte(wr * 64 + fr, fq * 8), boff = lds_byte(wc * 32 + fr, fq * 8);
#define PG8_SA(b, h) (((b) * 2 + (h)) * HTB)
#define PG8_SB(b, h) ((4 + (b) * 2 + (h)) * HTB)
#define PG8_STAGE(bufoff, gbase, voff) do { _Pragma("unroll") for (int _i = 0; _i < 2; ++_i) \
        __builtin_amdgcn_global_load_lds((const unsigned*)((const char*)(gbase) + (voff)[_i]), (PG8_LAS unsigned*)(lds + (bufoff) + ldsw + _i * 8192), 16, 0, 0); } while (0)
#define PG8_LD8(p) __builtin_shufflevector(*(const PG8_LAS i32x4_t*)(p), *(const PG8_LAS i32x4_t*)((p) + 1024), 0, 1, 2, 3, 4, 5, 6, 7)
#define PG8_LDA(dst, b, h) do { _Pragma("unroll") for (int m = 0; m < 4; ++m) { if constexpr (F8) dst##8[m] = PG8_LD8(lds + PG8_SA(b, h) + aoff + m * 2048); else { _Pragma("unroll") for (int k = 0; k < 2; ++k) dst[m][k] = *(const PG8_LAS bf16x8*)(lds + PG8_SA(b, h) + aoff + m * 2048 + k * 1024); } } } while (0)
#define PG8_LDB(dst, b, h) do { _Pragma("unroll") for (int n = 0; n < 2; ++n) { if constexpr (F8) dst##8[n] = PG8_LD8(lds + PG8_SB(b, h) + boff + n * 2048); else { _Pragma("unroll") for (int k = 0; k < 2; ++k) dst[n][k] = *(const PG8_LAS bf16x8*)(lds + PG8_SB(b, h) + boff + n * 2048 + k * 1024); } } } while (0)
#define PG8_MMA(ai, bj, At, Bt) do { __builtin_amdgcn_s_setprio(1); _Pragma("unroll") for (int m = 0; m < 4; ++m) _Pragma("unroll") for (int n = 0; n < 2; ++n) { \
        if constexpr (F8) asm volatile("v_mfma_scale_f32_16x16x128_f8f6f4 %0, %1, %2, %0, %3, %3 op_sel_hi:[0,0,0]" : "+v"(acc[ai][bj][m][n]) : "v"(Bt##8[n]), "v"(At##8[m]), "v"(scl8)); \
        else if constexpr (I8) { _Pragma("unroll") for (int k = 0; k < 2; ++k) acc[ai][bj][m][n] = __builtin_bit_cast(f32x4, __builtin_amdgcn_mfma_i32_16x16x64_i8(__builtin_bit_cast(i32x4_t, Bt[n][k]), __builtin_bit_cast(i32x4_t, At[m][k]), __builtin_bit_cast(i32x4_t, acc[ai][bj][m][n]), 0, 0, 0)); } \
        else { _Pragma("unroll") for (int k = 0; k < 2; ++k) acc[ai][bj][m][n] = __builtin_amdgcn_mfma_f32_16x16x32_bf16(Bt[n][k], At[m][k], acc[ai][bj][m][n], 0, 0, 0); } } __builtin_amdgcn_s_setprio(0); } while (0)
#define PG8_WAIT_V(n) asm volatile("s_waitcnt vmcnt(" #n ")" ::: "memory")
#define PG8_WAIT_L(n) asm volatile("s_waitcnt lgkmcnt(" #n ")" ::: "memory")
#define PG8_BAR __builtin_amdgcn_s_barrier()
#define PG8_SCHED __builtin_amdgcn_sched_barrier(0)
    Unit cur, nxt; int ui = 0;
    if (!S.next(0, cur)) return;
    f32x4 acc[2][2][4][2];
#pragma unroll
    for (int a = 0; a < 2; ++a)
#pragma unroll
        for (int b = 0; b < 2; ++b)
#pragma unroll
            for (int m = 0; m < 4; ++m)
#pragma unroll
                for (int n = 0; n < 2; ++n) acc[a][b][m][n] = (f32x4){0.f, 0.f, 0.f, 0.f};
    bf16x8 At[4][2], B0[2][2], B1[2][2]; i32x8_t At8[4], B08[2], B18[2]; const int scl8 = 0x7c7c7c7c;
    const char* cA = (const char*)g.A + (size_t)cur.am * tstep + cur.kb; const char* cB = (const char*)g.Bt + (size_t)cur.pn * tstep + cur.kb;
    S.a_ready(cur);
    if constexpr (SP2) {
        PG8_STAGE(PG8_SB(0, 0), cB, voffB); PG8_STAGE(PG8_SB(0, 1), cB + hstep, voffB); PG8_STAGE(PG8_SA(0, 0), cA, voffA); PG8_STAGE(PG8_SA(0, 1), cA + hstep, voffA);
        if (wr == 1) PG8_BAR;
        PG8_WAIT_V(2); PG8_BAR;
        PG8_STAGE(PG8_SB(1, 0), cB + kstep, voffB); PG8_STAGE(PG8_SA(1, 0), cA + kstep, voffA); PG8_STAGE(PG8_SB(1, 1), cB + hstep + kstep, voffB);
        PG8_WAIT_V(6); PG8_BAR;
    } else {
        PG8_STAGE(PG8_SB(0, 0), cB, voffB); PG8_STAGE(PG8_SA(0, 0), cA, voffA); PG8_STAGE(PG8_SB(0, 1), cB + hstep, voffB); PG8_STAGE(PG8_SA(0, 1), cA + hstep, voffA);
        if (wr == 1) PG8_BAR;
        PG8_WAIT_V(4); PG8_BAR;
        PG8_STAGE(PG8_SB(1, 0), cB + kstep, voffB); PG8_STAGE(PG8_SA(1, 0), cA + kstep, voffA); PG8_STAGE(PG8_SB(1, 1), cB + hstep + kstep, voffB);
        PG8_WAIT_V(6); PG8_BAR;
    }
    for (;;) {
        const bool has_next = S.next(ui + 1, nxt);
        const char* nA = has_next ? (const char*)g.A + (size_t)nxt.am * tstep + nxt.kb : cA; const char* nB = has_next ? (const char*)g.Bt + (size_t)nxt.pn * tstep + nxt.kb : cB;
        for (int t = 0; t < nt; t += 2) {
            const bool last = (t == nt - 2);
            const char* a1 = cA + (size_t)(t + 1) * kstep;
            const char* a2 = last ? nA : cA + (size_t)(t + 2) * kstep; const char* b2 = last ? nB : cB + (size_t)(t + 2) * kstep;
            const char* a3 = a2 + kstep; const char* b3 = b2 + kstep;
            if (last && has_next) S.a_ready(nxt);
            if constexpr (SP2) {
            PG8_LDB(B0, 0, 0); PG8_LDB(B1, 0, 1); PG8_SCHED; PG8_LDA(At, 0, 0); PG8_STAGE(PG8_SA(1, 1), a1 + hstep, voffA);
            PG8_WAIT_V(8); PG8_WAIT_L(0); PG8_BAR; PG8_MMA(0, 0, At, B0); PG8_MMA(0, 1, At, B1); PG8_BAR; PG8_SCHED;
            if constexpr (!HALF_M) PG8_LDA(At, 0, 1); PG8_STAGE(PG8_SB(0, 0), b2, voffB); PG8_STAGE(PG8_SB(0, 1), b2 + hstep, voffB); PG8_STAGE(PG8_SA(0, 0), a2, voffA);
            PG8_WAIT_V(8); PG8_WAIT_L(0); PG8_BAR; if constexpr (!HALF_M) PG8_MMA(1, 0, At, B0); if constexpr (!HALF_M) PG8_MMA(1, 1, At, B1); PG8_BAR; PG8_SCHED;
            PG8_LDB(B0, 1, 0); PG8_LDB(B1, 1, 1); PG8_SCHED; PG8_LDA(At, 1, 0); PG8_STAGE(PG8_SA(0, 1), a2 + hstep, voffA);
            PG8_WAIT_V(8); PG8_WAIT_L(0); PG8_BAR; PG8_MMA(0, 0, At, B0); PG8_MMA(0, 1, At, B1); PG8_BAR; PG8_SCHED;
            if constexpr (!HALF_M) PG8_LDA(At, 1, 1); PG8_STAGE(PG8_SB(1, 0), b3, voffB); PG8_STAGE(PG8_SB(1, 1), b3 + hstep, voffB); PG8_STAGE(PG8_SA(1, 0), a3, voffA);
            PG8_WAIT_V(8); PG8_WAIT_L(0); PG8_BAR; if constexpr (!HALF_M) PG8_MMA(1, 0, At, B0); if constexpr (!HALF_M) PG8_MMA(1, 1, At, B1); PG8_BAR; PG8_SCHED;
            } else {
            PG8_LDB(B0, 0, 0); PG8_SCHED; PG8_LDA(At, 0, 0); PG8_STAGE(PG8_SA(1, 1), a1 + hstep, voffA);
            PG8_WAIT_L(8); PG8_BAR; PG8_WAIT_L(0); PG8_MMA(0, 0, At, B0); PG8_BAR; PG8_SCHED;
            PG8_LDB(B1, 0, 1); PG8_STAGE(PG8_SB(0, 0), b2, voffB);
            PG8_BAR; PG8_WAIT_L(0); PG8_MMA(0, 1, At, B1); PG8_BAR;
            if constexpr (!HALF_M) PG8_LDA(At, 0, 1); PG8_STAGE(PG8_SA(0, 0), a2, voffA);
            PG8_BAR; PG8_WAIT_L(0); if constexpr (!HALF_M) PG8_MMA(1, 0, At, B0); PG8_BAR; PG8_SCHED;
            PG8_STAGE(PG8_SB(0, 1), b2 + hstep, voffB);
            PG8_WAIT_V(6); PG8_BAR; if constexpr (!HALF_M) PG8_MMA(1, 1, At, B1); PG8_BAR;
            PG8_LDB(B0, 1, 0); PG8_SCHED; PG8_LDA(At, 1, 0); PG8_STAGE(PG8_SA(0, 1), a2 + hstep, voffA);
            PG8_WAIT_L(8); PG8_BAR; PG8_WAIT_L(0); PG8_MMA(0, 0, At, B0); PG8_BAR; PG8_SCHED;
            PG8_LDB(B1, 1, 1); PG8_STAGE(PG8_SB(1, 0), b3, voffB);
            PG8_BAR; PG8_WAIT_L(0); PG8_MMA(0, 1, At, B1); PG8_BAR;
            if constexpr (!HALF_M) PG8_LDA(At, 1, 1); PG8_STAGE(PG8_SA(1, 0), a3, voffA);
            PG8_BAR; PG8_WAIT_L(0); if constexpr (!HALF_M) PG8_MMA(1, 0, At, B0); PG8_BAR; PG8_SCHED;
            PG8_STAGE(PG8_SB(1, 1), b3 + hstep, voffB);
            PG8_WAIT_V(6); PG8_BAR; if constexpr (!HALF_M) PG8_MMA(1, 1, At, B1); PG8_BAR;
            }
        }
        if constexpr (F8) { asm volatile("s_nop 15\n\ts_nop 15" ::: "memory"); }
        if constexpr (ALIGN_EPI) { if (wr == 0) PG8_BAR; }
        if constexpr (!Epi::AFTER_DRAIN) { E(acc, cur, wr, wc, fr, fq); S.done(cur); }
        if (!has_next) break;
#pragma unroll
        for (int a = 0; a < 2; ++a)
#pragma unroll
            for (int b = 0; b < 2; ++b)
#pragma unroll
                for (int m = 0; m < 4; ++m)
#pragma unroll
                    for (int n = 0; n < 2; ++n) acc[a][b][m][n] = (f32x4){0.f, 0.f, 0.f, 0.f};
        cur = nxt; cA = nA; cB = nB; ++ui;
        if constexpr (ALIGN_EPI) { if (wr == 1) PG8_BAR; }
    }
    PG8_WAIT_V(0);
    if constexpr (!ALIGN_EPI) { if (wr == 0) PG8_BAR; }
    PG8_BAR;
    if constexpr (Epi::AFTER_DRAIN) { E.fused(acc, cur, wr, wc, fr, fq, lds, wid, lane); S.done(cur); }
#undef PG8_SA
#undef PG8_SB
#undef PG8_STAGE
#undef PG8_LDA
#undef PG8_LDB
#undef PG8_MMA
#undef PG8_WAIT_V
#undef PG8_WAIT_L
#undef PG8_BAR
#undef PG8_SCHED
}
}

constexpr int NWAVES = 8;
#ifndef MK_N_LAUNCHES
#define MK_N_LAUNCHES 1
#endif
constexpr int NPHASE = 15;
constexpr int N_LAUNCHES = MK_N_LAUNCHES;

constexpr int DM = 4096, TSEQ = 2048, NBATCH = 4, MP = NBATCH * TSEQ  , MS = 128  , MROWS = MP + MS  , MPAD = 8448  ;
constexpr int DC = 2048, NH = 8, DKH = 256, DVH = 256, RANK = 16, DFF = 11008, NUP = 2 * DFF  , PLE = 256, CHUNK = 32, NCHUNK = TSEQ / CHUNK;
constexpr int DIN = 22544, NZ = 22528;
constexpr int ZH = 0, ZC = 2048, ZB = 4096, ZK = 6144, ZQ = 8192, ZV = 10240, ZR = 12288, ZGA = 14336, ZGB = 18432;
constexpr int ZI8 = 8192;
constexpr int ALR_SRC = 14336;
constexpr float EPS = 1e-6f;
constexpr int PADK = 64, LD4 = DM + PADK  , LD2 = DC + PADK  , LDF = DFF + PADK  , LDP = PLE + PADK  ;
static_assert(pg8::MROWS == MROWS, "rows");
constexpr size_t O_Y = 0, O_CP = (size_t)MROWS * DM, O_CS = O_CP + (size_t)NBATCH * 2 * DC, O_GP = O_CS + (size_t)MS * 2 * DC, O_GS = O_GP + (size_t)NBATCH * NH * DKH * DVH,
                 O_FP = O_GS + (size_t)MS * NH * DKH * DVH, O_FS = O_FP + (size_t)NBATCH * 2 * NUP, O_END = O_FS + (size_t)MS * 2 * NUP;
static_assert(O_END == 109637632, "output size");

constexpr size_t MiB = 1u << 20;
constexpr size_t WS_CTL = 0, CTL_ZERO_BYTES = 1 * MiB;
constexpr size_t WS_ALR = 12 * MiB;
constexpr size_t WS_SSQ4 = 1 * MiB;
constexpr size_t WS_RSTD = 2 * MiB;
constexpr size_t WS_PART = 3 * MiB;
constexpr size_t WS_PBF = 6 * MiB;
constexpr size_t WS_WIN = 16 * MiB;
constexpr size_t WS_PACK = WS_WIN, WS_T1 = WS_WIN, WS_UPA = WS_WIN;
constexpr size_t WS_WOA = 196 * MiB;
constexpr size_t WS_WOB = 213 * MiB;
constexpr size_t WS_WMIX = 230 * MiB;
constexpr size_t WS_WUP = 263 * MiB;
constexpr size_t WS_WDN = 438 * MiB;
constexpr size_t WS_WPG = 525 * MiB;
constexpr size_t WS_WPP = 558 * MiB;
constexpr size_t WS_XN = 561 * MiB;
constexpr size_t WS_Z = 629 * MiB;
constexpr size_t WS_UP = WS_Z, WS_PP = WS_Z;
constexpr size_t PS_BYTES = (size_t)16 * 128 * DM * 4;
constexpr size_t WS_O = WS_XN  ;
constexpr size_t WS_PS4 = WS_XN  , WS_PS6 = WS_T1  , WS_PS10 = WS_Z + 140 * MiB  , WS_PS12 = WS_PS10;
constexpr size_t WS_A2 = 992 * MiB;
constexpr size_t WS_B2 = 1027 * MiB;
constexpr size_t WS_MRG = 1062 * MiB;
constexpr size_t WS_WU8 = 1130 * MiB;
constexpr size_t WS_END = 1240 * MiB;
constexpr int LD8 = DM + 128;
constexpr size_t WS_WG8 = WS_WIN + (size_t)14336 * LD4 * 2  , WS_WPG8 = WS_WPG  ;
constexpr size_t WS_X8 = WS_A2  , WS_H8 = WS_B2  ;
static_assert((size_t)MPAD * LD8 <= (size_t)MPAD * LD2 * 2 && WS_WG8 + (size_t)8192 * LD8 <= WS_WOA, "e4m3 maps");
constexpr size_t WS_WMAX = WS_CTL + 512 * 1024  , WS_PARTM = WS_ALR  ;
constexpr size_t WS_WMAX1 = WS_CTL + 640 * 1024  , WS_AMX4 = WS_SSQ4 + 256 * 1024  , WS_W8 = WS_WU8  ;
constexpr int LDA8 = DFF + 128;
constexpr size_t WS_A8 = WS_WUP  , WS_WD8 = WS_WOA  ;
constexpr size_t WS_SWD = WS_RSTD + 256 * 1024  ;
static_assert(WS_A8 + (size_t)MPAD * LDA8 <= WS_WDN && WS_WD8 + (size_t)DM * LDA8 <= WS_WUP && WS_SWD + DM * 4 <= WS_PART, "down int8 maps");
constexpr size_t WS_WMAXP = WS_CTL + 768 * 1024  , WS_WPGI = 1220 * MiB  , WS_SWP = WS_RSTD + 288 * 1024  ;
static_assert(WS_WPGI + (size_t)DM * LD8 <= WS_END && WS_SWP + DM * 4 <= WS_PART, "ple int8 map");
constexpr int LDB8 = DC + 128;
constexpr size_t WS_B8 = WS_WU8  , WS_WOB8 = WS_WU8 + 60 * MiB  ;
constexpr size_t WS_SWB = WS_RSTD + 272 * 1024  ;
static_assert(WS_W8 + (size_t)14336 * LD8 <= WS_WOB8 && WS_WOB8 + (size_t)DM * LDB8 <= WS_END && (size_t)MPAD * LDB8 <= 60 * MiB && WS_SWB + DM * 4 <= WS_PART, "GLA out int8 maps");
constexpr size_t WS_RS2 = WS_RSTD + 64 * 1024  , WS_SW = WS_RSTD + 128 * 1024  , WS_H1Q = WS_B2  ;
static_assert(WS_SW + NUP * 4 <= WS_PART && WS_WU8 + (size_t)NUP * LD8 <= WS_END && (size_t)MPAD * 64 * 4 <= 4 * MiB, "int8 maps");
constexpr size_t WS_H3B = WS_MRG  ;
constexpr size_t WS_PS1 = WS_MRG  , WS_PS9 = WS_MRG  ;
static_assert((size_t)4 * 128 * NZ * 4 <= (size_t)MPAD * LD4 * 2 && (size_t)4 * 144 * NUP * 4 <= (size_t)MPAD * LD4 * 2, "PS1 / PS9 fit MRG");
static_assert(WS_WIN + (size_t)NZ * LD4 * 2 <= WS_WOA && WS_UPA + (size_t)MPAD * LDF * 2 <= WS_WOA && WS_T1 + (size_t)MPAD * DM * 4 <= WS_WOA, "ws map 1");
static_assert(WS_WOA + (size_t)DM * LD2 * 2 <= WS_WOB && WS_WOB + (size_t)DM * LD2 * 2 <= WS_WMIX && WS_WMIX + (size_t)DM * LD4 * 2 <= WS_WUP && WS_WPG + (size_t)DM * LD4 * 2 <= WS_WPP && WS_WPP + (size_t)DM * LDP * 2 <= WS_XN, "ws map 1b");
static_assert(WS_WUP + (size_t)NUP * LD4 * 2 <= WS_WDN && WS_WDN + (size_t)DM * LDF * 2 <= WS_WPG && WS_XN + (size_t)MPAD * LD4 * 2 <= WS_Z && WS_Z + (size_t)MPAD * NZ * 2 <= WS_A2, "ws map 2");
static_assert(WS_A2 + (size_t)MPAD * LD2 * 2 <= WS_B2 && WS_B2 + (size_t)MPAD * LD2 * 2 <= WS_MRG && WS_MRG + (size_t)MPAD * LD4 * 2 <= WS_END && WS_PBF + (size_t)MPAD * LDP * 2 <= WS_ALR && WS_ALR + (size_t)4 * MROWS * 16 * 4 <= WS_WIN, "ws map 3");
constexpr int QTF_OFF = 0, KTF_OFF = 16384, VF_OFF = 32768, PF_OFF = 49152, DEC_OFF = 51200, PACK_BYTES = 52224;
static_assert(WS_PACK + (size_t)NBATCH * NCHUNK * NH * PACK_BYTES <= WS_WOA, "packs fit");
constexpr int CW_TMO = 0, CW_BAR = 4096;

constexpr int RING_OFF = 0, RING_BYTES = 131072;
constexpr int LDSCTL_OFF = 155648, MISC_OFF = LDSCTL_OFF + 320;
constexpr int LDS_BYTES = 163840;
static_assert(MISC_OFF + 128 <= LDS_BYTES, "LDS map");

#define GAS __attribute__((address_space(1)))
#define LAS __attribute__((address_space(3)))
typedef unsigned short bf16;
typedef unsigned v4u __attribute__((ext_vector_type(4)));
typedef unsigned v2u __attribute__((ext_vector_type(2)));
typedef float f32x4 __attribute__((ext_vector_type(4)));
typedef float f32x16 __attribute__((ext_vector_type(16)));
typedef short bf16x8 __attribute__((ext_vector_type(8)));
typedef GAS unsigned gu32;
#define RLX_AGENT __ATOMIC_RELAXED, __HIP_MEMORY_SCOPE_AGENT
#define LDS_WAIT() asm volatile("s_waitcnt lgkmcnt(0)" ::: "memory")
#define VM_WAIT() asm volatile("s_waitcnt vmcnt(0)" ::: "memory")
using pg8::pk2; using pg8::bflo; using pg8::bfhi; using pg8::pk8; using pg8::unpk8; using pg8::sigm;
__device__ __forceinline__ float ex2(float x) { return __builtin_amdgcn_exp2f(x); }
__device__ __forceinline__ float expf_fast(float x) { return __builtin_amdgcn_exp2f(1.44269504089f * x); }
__device__ __forceinline__ float logsig(float x) { return fminf(x, 0.f) - 0.69314718056f * __builtin_amdgcn_logf(1.0f + expf_fast(-fabsf(x))); }
__device__ __forceinline__ float silu(float x) { return x * sigm(x); }
__device__ __forceinline__ float wave_sum(float v) {
#pragma unroll
    for (int o = 1; o < 64; o <<= 1) v += __shfl_xor(v, o);
    return v;
}
#define MFMA32(a, b, c) __builtin_amdgcn_mfma_f32_32x32x16_bf16((a), (b), (c), 0, 0, 0)
#define FWHT_LANE(ctrl_, m_) do { const float sg_ = (lane & (m_)) ? -1.0f : 1.0f; _Pragma("unroll") for (int q_ = 0; q_ < 4; ++q_) { \
        const float ta_ = __int_as_float(__builtin_amdgcn_mov_dpp(__float_as_int(a[q_]), (ctrl_), 0xf, 0xf, true)), tb_ = __int_as_float(__builtin_amdgcn_mov_dpp(__float_as_int(b[q_]), (ctrl_), 0xf, 0xf, true)); \
        a[q_] = fmaf(a[q_], sg_, ta_); b[q_] = fmaf(b[q_], sg_, tb_); } } while (0)
__device__ __forceinline__ void fwht32(f32x4& a, int lane) {
    a = (f32x4){a[0] + a[1], a[0] - a[1], a[2] + a[3], a[2] - a[3]};
    a = (f32x4){a[0] + a[2], a[1] + a[3], a[0] - a[2], a[1] - a[3]};
#define FWHT_LANE4(ctrl_, m_) do { const float sg_ = (lane & (m_)) ? -1.0f : 1.0f; _Pragma("unroll") for (int q_ = 0; q_ < 4; ++q_) { \
        const float ta_ = __int_as_float(__builtin_amdgcn_mov_dpp(__float_as_int(a[q_]), (ctrl_), 0xf, 0xf, true)); a[q_] = fmaf(a[q_], sg_, ta_); } } while (0)
    FWHT_LANE4(0xB1, 1); FWHT_LANE4(0x4E, 2); FWHT_LANE4(0x128, 8);
#undef FWHT_LANE4
}
__device__ __forceinline__ void fwht64(f32x4& a, f32x4& b, int lane) {
    { const f32x4 s = a + b, d = a - b; a = s; b = d; }
    { const f32x4 ta = (f32x4){a[0] + a[2], a[1] + a[3], a[0] - a[2], a[1] - a[3]}, tb = (f32x4){b[0] + b[2], b[1] + b[3], b[0] - b[2], b[1] - b[3]}; a = ta; b = tb; }
    { const f32x4 ta = (f32x4){a[0] + a[1], a[0] - a[1], a[2] + a[3], a[2] - a[3]}, tb = (f32x4){b[0] + b[1], b[0] - b[1], b[2] + b[3], b[2] - b[3]}; a = ta; b = tb; }
    FWHT_LANE(0xB1, 1); FWHT_LANE(0x4E, 2); FWHT_LANE(0x128, 8);
}

#define XB_TMO      128
#define XB_XCNT(j)  (256  + 64 * (j))
#define XB_XSUB(j)  (1280 + 64 * (j))
#define XB_XGEN(j)  (2304 + 64 * (j))
#define XB_TOP      3328
#define XB_TOPGEN   3392
#define XCD_BAR_WORDS 3456
#define XB_SPIN_CAP (1u << 18)

__device__ __forceinline__ unsigned xb_ld(unsigned* p)              { return __hip_atomic_load(p, __ATOMIC_RELAXED, __HIP_MEMORY_SCOPE_AGENT); }
__device__ __forceinline__ unsigned xb_add(unsigned* p, unsigned v) { return __hip_atomic_fetch_add(p, v, __ATOMIC_RELAXED, __HIP_MEMORY_SCOPE_AGENT); }
__device__ __forceinline__ unsigned xb_xcc_id() { return (unsigned)__builtin_amdgcn_s_getreg((3 << 11) | 20) & 0xFu; }
#define XB_SPIN(cond, bar) do { unsigned _sp = 0; while (cond) { __builtin_amdgcn_s_sleep(1); \
    if ((++_sp & 255u) == 0u) { if (xb_ld(&(bar)[XB_TMO])) break; if (_sp > XB_SPIN_CAP) { atomicAdd(&(bar)[XB_TMO], 1u); break; } } } } while (0)

struct XcdBarrier {
    unsigned* bar; unsigned x;
    volatile LAS unsigned* st;
};

__device__ __forceinline__ XcdBarrier xcd_barrier_post(unsigned* bar, volatile LAS unsigned* st) {
    XcdBarrier b; b.bar = bar; b.x = xb_xcc_id(); b.st = st;
    if (threadIdx.x == 0) (void)xb_add(&bar[XB_XCNT(b.x)], 1u);
    return b;
}
__device__ __forceinline__ void xcd_barrier_complete(unsigned* bar, unsigned x, unsigned& nloc, unsigned& nx) {
    const unsigned G = gridDim.x * gridDim.y * gridDim.z;
    unsigned sum, cnt, mine, sp = 0u;
    for (;;) {
        sum = 0u; cnt = 0u; mine = 0u;
#pragma unroll
        for (unsigned j = 0; j < 16; ++j) { const unsigned c = xb_ld(&bar[XB_XCNT(j)]); sum += c; cnt += (c > 0u) ? 1u : 0u; mine = (j == x) ? c : mine; }
        if (sum == G) break;
        __builtin_amdgcn_s_sleep(1);
        if ((++sp & 255u) == 0u) { if (xb_ld(&bar[XB_TMO])) break; if (sp > XB_SPIN_CAP) { atomicAdd(&bar[XB_TMO], 1u); break; } }
    }
    nloc = mine > 0u ? mine : 1u; nx = cnt > 0u ? cnt : 1u;
}

__device__ __forceinline__ void xcd_barrier(const XcdBarrier& b) {
    asm volatile("s_waitcnt vmcnt(0)" ::: "memory");
    __syncthreads();
    if (threadIdx.x == 0) {
        unsigned* bar = b.bar;
        __builtin_amdgcn_s_waitcnt(0);
        unsigned nloc = b.st[0], nx = b.st[1];
        if (nloc == 0u) { xcd_barrier_complete(bar, b.x, nloc, nx); b.st[0] = nloc; b.st[1] = nx; }
        const unsigned old = xb_add(&bar[XB_XSUB(b.x)], 1u);
        const unsigned gen = old / nloc;
        if (old + 1u == (gen + 1u) * nloc) {
            __builtin_amdgcn_fence(__ATOMIC_RELEASE, "agent");
            asm volatile("s_waitcnt vmcnt(0)" ::: "memory");
            const unsigned og = xb_add(&bar[XB_TOP], 1u);
            const unsigned tg = og / nx;
            if (og + 1u == (tg + 1u) * nx) xb_add(&bar[XB_TOPGEN], 1u);
            else XB_SPIN(xb_ld(&bar[XB_TOPGEN]) == tg, bar);
            __builtin_amdgcn_fence(__ATOMIC_ACQUIRE, "agent");
            xb_add(&bar[XB_XGEN(b.x)], 1u);
            asm volatile("s_waitcnt vmcnt(0)" ::: "memory");
        } else {
            XB_SPIN(xb_ld(&bar[XB_XGEN(b.x)]) == gen, bar);
            __builtin_amdgcn_fence(__ATOMIC_ACQUIRE, "agent");
            asm volatile("s_waitcnt vmcnt(0)" ::: "memory");
        }
    }
    __syncthreads();
}

__device__ __forceinline__ const float* inptr(int i) {
    const void* ka = (const void*)__builtin_amdgcn_kernarg_segment_ptr(); const float* p;
    asm volatile("s_load_dwordx2 %0, %1, %2\n\ts_waitcnt lgkmcnt(0)" : "=s"(p) : "s"(ka), "i"(i * 8) : "memory");
    return p;
}
struct Args {
    const float* in[24]; float* out; unsigned char* ws; int ph_lo, ph_hi;
};
struct Frame {
    LAS unsigned char* lds;
    int vcu, G;
};
__device__ __forceinline__ int fresh_tid() { int t; asm volatile("v_mov_b32 %0, %1" : "=v"(t) : "v"(threadIdx.x)); return t; }
#define PHASE_IDS const int tid = fresh_tid(), lane = tid & 63, wave = __builtin_amdgcn_readfirstlane(tid >> 6), gw = F.vcu * NWAVES + wave; (void)gw; (void)lane; (void)tid

struct TrB { const float* src; unsigned char* dst; const float* gain; unsigned* mx; int ldn, ldkb, nk64, f8; };
#define TRM(W, K_, N_, LDN_, SRC0_, GAIN_, DSTOFF_, LDKB_, F8_, MX_) { constexpr int nblk_ = (N_) / 64, nkb_ = ((K_) + 511) / 512, cnt_ = nkb_ * nblk_; if (r < cnt_) { const int kb = r / nblk_, nb = r - kb * nblk_, n0 = 64 * nb, k0 = 512 * kb; \
        T.src = (W) + (size_t)k0 * (LDN_) + (SRC0_) + n0; T.ldn = (LDN_); T.gain = (GAIN_) ? (GAIN_) + k0 : nullptr; T.dst = ws + (DSTOFF_) + (size_t)n0 * (LDKB_) + (size_t)k0 * ((F8_) ? 1 : 2); T.ldkb = (LDKB_); T.f8 = (F8_); T.mx = (MX_) ? (unsigned*)(ws + (MX_)) + n0 : nullptr; T.nk64 = ((K_) - k0) / 64; return true; } r -= cnt_; }
__device__ __forceinline__ bool tr_decode(int it, TrB& T, const float* w_in, const float* w_out_conv, const float* w_out_gla, const float* w_mix_out, const float* w_up, const float* w_down, const float* w_ple_gate, const float* w_ple_proj,
                                          const float* g_ffn, const float* g_ple, unsigned char* ws) {
    int r = it; const float* nog = nullptr;
    TRM(w_in, DM, 6144, DIN, 0, nog, WS_WIN, LD4 * 2, 0, 0)
    TRM(w_in, DM, 2048, DIN, 8192, nog, WS_WIN + (size_t)ZK * LD4 * 2, LD4 * 2, 0, 0)
    TRM(w_in, DM, 2048, DIN, 6144, nog, WS_WIN + (size_t)ZQ * LD4 * 2, LD4 * 2, 0, WS_WMAX1 + 4 * ZQ)
    TRM(w_in, DM, 4096, DIN, 10240, nog, WS_WIN + (size_t)ZV * LD4 * 2, LD4 * 2, 0, WS_WMAX1 + 4 * ZV)
    TRM(w_in, DM, 8192, DIN, ALR_SRC + RANK, nog, WS_WIN + (size_t)ZGA * LD4 * 2, LD4 * 2, 0, WS_WMAX1 + 4 * ZGA)
    TRM(w_up, DM, NUP, NUP, 0, g_ffn, WS_WUP, LD4 * 2, 0, WS_WMAX)
    TRM(w_down, DFF, DM, DM, 0, nog, WS_WDN, LDF * 2, 0, 0)
    TRM(w_out_conv, DC, DM, DM, 0, nog, WS_WOA, LD2 * 2, 0, 0)
    TRM(w_out_gla, DC, DM, DM, 0, nog, WS_WOB, LD2 * 2, 0, 0)
    TRM(w_mix_out, DM, DM, DM, 0, nog, WS_WMIX, LD4 * 2, 0, 0)
    TRM(w_ple_gate, DM, DM, DM, 0, g_ple, WS_WPG, LD4 * 2, 0, WS_WMAXP)
    TRM(w_ple_proj, PLE, DM, DM, 0, nog, WS_WPP, LDP * 2, 0, 0)
    return false;
}

#define QUANT_ROW(srcp, dstp, inv) do { v4u w_[8]; _Pragma("unroll") for (int j_ = 0; j_ < 8; ++j_) w_[j_] = *(const v4u*)((srcp) + 512 * j_ + 8 * lane); \
            _Pragma("unroll") for (int j_ = 0; j_ < 8; ++j_) { f32x4 a_, b_; unpk8(w_[j_], a_, b_); unsigned q_[8]; \
                _Pragma("unroll") for (int e_ = 0; e_ < 4; ++e_) { q_[e_] = __float_as_uint(fmaf(a_[e_], (inv), 12582912.0f)); q_[4 + e_] = __float_as_uint(fmaf(b_[e_], (inv), 12582912.0f)); } \
                v2u o_; o_.x = __builtin_amdgcn_perm(q_[1], q_[0], 0x0c0c0400u) | __builtin_amdgcn_perm(q_[3], q_[2], 0x04000c0cu); o_.y = __builtin_amdgcn_perm(q_[5], q_[4], 0x0c0c0400u) | __builtin_amdgcn_perm(q_[7], q_[6], 0x04000c0cu); \
                *(v2u*)((dstp) + 512 * j_ + 8 * lane) = o_; } } while (0)

__global__ void __launch_bounds__(NWAVES * 64, 2) mega_fwd(Args args) {
    extern __shared__ __attribute__((aligned(16))) unsigned char lds[];
    Frame F;
    F.lds = (LAS unsigned char*)lds;
    volatile LAS unsigned* MISC = (volatile LAS unsigned*)(F.lds + MISC_OFF);
    F.G = gridDim.x; { const int bx = blockIdx.x; F.vcu = (F.G % 8 == 0) ? (bx % 8) * (F.G / 8) + bx / 8 : bx; }
    unsigned char* ws = args.ws;
    gu32* ctl = (gu32*)(ws + WS_CTL);
    const int NGW = F.G * NWAVES;

    float* out = args.out;
    float* ALR = (float*)(ws + WS_ALR); float* SSQ4 = (float*)(ws + WS_SSQ4); float* RSTD = (float*)(ws + WS_RSTD); float* PART = (float*)(ws + WS_PART); bf16* PBF = (bf16*)(ws + WS_PBF);
    bf16* WIN = (bf16*)(ws + WS_WIN); bf16* WOA = (bf16*)(ws + WS_WOA); bf16* WOB = (bf16*)(ws + WS_WOB); bf16* WMIX = (bf16*)(ws + WS_WMIX);
    bf16* WUP = (bf16*)(ws + WS_WUP); bf16* WDN = (bf16*)(ws + WS_WDN); bf16* WPG = (bf16*)(ws + WS_WPG); bf16* WPP = (bf16*)(ws + WS_WPP);
    bf16* XN = (bf16*)(ws + WS_XN); bf16* Z = (bf16*)(ws + WS_Z); bf16* UP = (bf16*)(ws + WS_UP); bf16* PP = (bf16*)(ws + WS_PP);
    bf16* A2 = (bf16*)(ws + WS_A2); bf16* B2 = (bf16*)(ws + WS_B2); bf16* MRG = (bf16*)(ws + WS_MRG); float* T1 = (float*)(ws + WS_T1); bf16* UPA = (bf16*)(ws + WS_UPA);
    unsigned char* PACK = ws + WS_PACK;

    for (int u = threadIdx.x; u < (LDS_BYTES - LDSCTL_OFF) / 4; u += NWAVES * 64) ((LAS unsigned*)(F.lds + LDSCTL_OFF))[u] = 0u;
    __syncthreads();
    XcdBarrier bar; bar.bar = (unsigned*)(ctl + CW_BAR); bar.x = 0; bar.st = nullptr;
    if (N_LAUNCHES == 1) bar = xcd_barrier_post((unsigned*)(ctl + CW_BAR), MISC + 8);
#define GRID_BAR(seam) do { if (N_LAUNCHES != 1) { if (threadIdx.x == 0) __hip_atomic_store(ctl + CW_TMO, 0xBADBA0u | (unsigned)(seam), RLX_AGENT); } else { xcd_barrier(bar); } } while (0)
    const int lo = args.ph_lo, hi = args.ph_hi;
#ifdef ONLY_PHASE
#define IN(k) ((k) == ONLY_PHASE && lo <= (k) && (k) < hi)
#else
#define IN(k) (lo <= (k) && (k) < hi)
#endif
#define BOTH(k) (IN(k) && IN((k) + 1))
#ifndef DUP_MASK
#define DUP_MASK 0
#endif
#define REP(k) for (int rep_ = 0; rep_ < 1 + ((DUP_MASK >> (k)) & 1); ++rep_)

    if (IN(0)) { REP(0) {
        PHASE_IDS;
        const float* x_prompt = inptr(0); const float* x_sample = inptr(1); const float* p_prompt = inptr(2); const float* p_sample = inptr(3); const float* g_mix = inptr(7); const float* w_in = inptr(8); const float* w_out_conv = inptr(12); const float* w_out_gla = inptr(14); const float* w_mix_out = inptr(15); const float* g_ffn = inptr(16); const float* w_up = inptr(17); const float* w_down = inptr(19); const float* g_ple = inptr(20); const float* w_ple_gate = inptr(21); const float* w_ple_proj = inptr(22);
        { int j = wave * F.G + F.vcu; bool extra_done = false;
        while (j < (MROWS / 16) * 4) {
            const int ks = j & 3, row0 = 16 * (j >> 2), rl = lane & 15, kq = lane >> 4, row = row0 + rl, kb = 1024 * ks;
            const float* xr = (row < MP ? x_prompt + (size_t)row * DM : x_sample + (size_t)(row - MP) * DM) + kb + 8 * kq;
            float ss = 0.f;
            f32x4 acc = (f32x4){0.f, 0.f, 0.f, 0.f};
            const float* wb = w_in + (size_t)(kb + 8 * kq) * DIN + ALR_SRC + rl;
            bf16* xo = XN + (size_t)row * LD4 + kb + 8 * kq; float amx = 0.f;
#pragma unroll 4
            for (int sI = 0; sI < 1024 / 32; ++sI) {
                const f32x4 xa = *(const f32x4*)(xr + 32 * sI), xb = *(const f32x4*)(xr + 32 * sI + 4);
                const f32x4 ga = *(const f32x4*)(g_mix + kb + 32 * sI + 8 * kq), gb = *(const f32x4*)(g_mix + kb + 32 * sI + 8 * kq + 4);
                float w8[8];
#pragma unroll
                for (int jj = 0; jj < 8; ++jj) w8[jj] = wb[(size_t)(32 * sI + jj) * DIN];
                ss += ((xa[0] * xa[0] + xa[1] * xa[1]) + (xa[2] * xa[2] + xa[3] * xa[3])) + ((xb[0] * xb[0] + xb[1] * xb[1]) + (xb[2] * xb[2] + xb[3] * xb[3]));
                const f32x4 ya = xa * ga, yb = xb * gb; const v4u av = pk8(ya, yb);
                *(v4u*)(xo + 32 * sI) = av;
                amx = fmaxf(amx, fmaxf(fmaxf(fmaxf(fabsf(ya[0]), fabsf(ya[1])), fmaxf(fabsf(ya[2]), fabsf(ya[3]))), fmaxf(fmaxf(fabsf(yb[0]), fabsf(yb[1])), fmaxf(fabsf(yb[2]), fabsf(yb[3])))));
                v4u bh, bl;
                bh.x = pk2(w8[0], w8[1]); bh.y = pk2(w8[2], w8[3]); bh.z = pk2(w8[4], w8[5]); bh.w = pk2(w8[6], w8[7]);
                bl.x = pk2(w8[0] - bflo(bh.x), w8[1] - bfhi(bh.x)); bl.y = pk2(w8[2] - bflo(bh.y), w8[3] - bfhi(bh.y)); bl.z = pk2(w8[4] - bflo(bh.z), w8[5] - bfhi(bh.z)); bl.w = pk2(w8[6] - bflo(bh.w), w8[7] - bfhi(bh.w));
                acc = __builtin_amdgcn_mfma_f32_16x16x32_bf16(__builtin_bit_cast(bf16x8, av), __builtin_bit_cast(bf16x8, bh), acc, 0, 0, 0);
                acc = __builtin_amdgcn_mfma_f32_16x16x32_bf16(__builtin_bit_cast(bf16x8, av), __builtin_bit_cast(bf16x8, bl), acc, 0, 0, 0);
            }
            ss += __shfl_xor(ss, 16); ss += __shfl_xor(ss, 32);
            amx = fmaxf(amx, __shfl_xor(amx, 16)); amx = fmaxf(amx, __shfl_xor(amx, 32));
            if (kq == 0) { SSQ4[(size_t)row * 4 + ks] = ss; ((float*)(ws + WS_AMX4))[(size_t)row * 4 + ks] = amx; }
#pragma unroll
            for (int e = 0; e < 4; ++e) ALR[((size_t)ks * MROWS + row0 + 4 * kq + e) * 16 + rl] = acc[e];
                    if (F.G == 256) { if (!extra_done && wave == 0 && F.vcu >= 128 && F.vcu < 160) { j = 2048 + F.vcu - 128; extra_done = true; } else break; } else j += NWAVES * F.G;
        } }
        {
            LAS float* scr = (LAS float*)(F.lds + RING_OFF + wave * 16640);
            TrB cur, nxt; f32x4 lc[16], ln[16];
            int it = F.vcu; bool has = tr_decode(it, cur, w_in, w_out_conv, w_out_gla, w_mix_out, w_up, w_down, w_ple_gate, w_ple_proj, g_ffn, g_ple, ws);
            if (has && wave < cur.nk64) {
#pragma unroll
                for (int i = 0; i < 16; ++i) lc[i] = *(const f32x4*)(cur.src + (size_t)(64 * wave + 4 * i + (lane >> 4)) * cur.ldn + 4 * (lane & 15));
            }
            while (has) {
                const int itn = it + F.G; const bool hasn = tr_decode(itn, nxt, w_in, w_out_conv, w_out_gla, w_mix_out, w_up, w_down, w_ple_gate, w_ple_proj, g_ffn, g_ple, ws);
                if (hasn && wave < nxt.nk64) {
#pragma unroll
                    for (int i = 0; i < 16; ++i) ln[i] = *(const f32x4*)(nxt.src + (size_t)(64 * wave + 4 * i + (lane >> 4)) * nxt.ldn + 4 * (lane & 15));
                }
                if (wave < cur.nk64) {
#pragma unroll
                    for (int i = 0; i < 16; ++i) { LAS float* d = scr + (4 * i + (lane >> 4)) * 65 + 4 * (lane & 15); d[0] = lc[i][0]; d[1] = lc[i][1]; d[2] = lc[i][2]; d[3] = lc[i][3]; }
                    LDS_WAIT(); asm volatile("" ::: "memory");
                    { const int c = lane & 7; f32x4 g0 = (f32x4){1.f, 1.f, 1.f, 1.f}, g1 = g0;
                      if (cur.gain) { g0 = *(const f32x4*)(cur.gain + 64 * wave + 8 * c); g1 = *(const f32x4*)(cur.gain + 64 * wave + 8 * c + 4); }
#pragma unroll
                      for (int jq = 0; jq < 8; ++jq) { const int n = (lane >> 3) + 8 * jq; const LAS float* sp = scr + (8 * c) * 65 + n;
                          const float e0 = sp[0 * 65] * g0[0], e1 = sp[1 * 65] * g0[1], e2 = sp[2 * 65] * g0[2], e3 = sp[3 * 65] * g0[3], e4 = sp[4 * 65] * g1[0], e5 = sp[5 * 65] * g1[1], e6 = sp[6 * 65] * g1[2], e7 = sp[7 * 65] * g1[3];
                          if (cur.mx) { float am = fmaxf(fmaxf(fmaxf(fabsf(e0), fabsf(e1)), fmaxf(fabsf(e2), fabsf(e3))), fmaxf(fmaxf(fabsf(e4), fabsf(e5)), fmaxf(fabsf(e6), fabsf(e7))));
                              am = fmaxf(am, __shfl_xor(am, 1)); am = fmaxf(am, __shfl_xor(am, 2)); am = fmaxf(am, __shfl_xor(am, 4));
                              if (c == 0) __hip_atomic_fetch_max(cur.mx + n, __float_as_uint(am), RLX_AGENT); }
                          if (cur.f8) { v2u o; o.x = pg8::pk4f8(e0 * 64.f, e1 * 64.f, e2 * 64.f, e3 * 64.f); o.y = pg8::pk4f8(e4 * 64.f, e5 * 64.f, e6 * 64.f, e7 * 64.f); *(v2u*)(cur.dst + (size_t)n * cur.ldkb + 64 * wave + 8 * c) = o; }
                          else { v4u o; o.x = pk2(e0, e1); o.y = pk2(e2, e3); o.z = pk2(e4, e5); o.w = pk2(e6, e7); *(v4u*)(cur.dst + (size_t)n * cur.ldkb + 2 * (64 * wave + 8 * c)) = o; } } }
                    LDS_WAIT(); asm volatile("" ::: "memory");
                }
                cur = nxt; it = itn; has = hasn;
#pragma unroll
                for (int i = 0; i < 16; ++i) lc[i] = ln[i];
            }
        }
        for (int row = gw; row < MPAD; row += NGW) {
            f32x4 pv = (f32x4){0.f, 0.f, 0.f, 0.f};
            if (row < MROWS) { const float* pr = row < MP ? p_prompt + (size_t)row * PLE : p_sample + (size_t)(row - MP) * PLE; pv = *(const f32x4*)(pr + 4 * lane); }
            v2u o; o.x = pk2(pv[0], pv[1]); o.y = pk2(pv[2], pv[3]);
            *(v2u*)(PBF + (size_t)row * LDP + 4 * lane) = o;
        }
        }
        if (BOTH(0)) GRID_BAR(0);
    }

    if (IN(1)) { REP(1) {
        { PHASE_IDS; float* RS1 = (float*)(ws + WS_RS2); float* SW1 = (float*)(ws + WS_SW);
          for (int row = gw; row < MP; row += NGW) { const f32x4 a4 = *(const f32x4*)((const float*)(ws + WS_AMX4) + 4 * (size_t)row), q4 = *(const f32x4*)(SSQ4 + 4 * (size_t)row);
              const float am = fmaxf(fmaxf(fmaxf(a4[0], a4[1]), fmaxf(a4[2], a4[3])), 1e-30f), rstd = 1.0f / sqrtf(((q4[0] + q4[1]) + (q4[2] + q4[3])) * (1.0f / 4096.0f) + 1e-6f);
              if (lane == 0) RS1[row] = rstd * am * (1.0f / 127.0f);
              const float inv = 127.0f / am;
              QUANT_ROW(XN + (size_t)row * LD4, ws + WS_X8 + (size_t)row * LD8, inv); }
          for (int n = ZI8 + gw; n < NZ; n += NGW) { const float am = fmaxf(__uint_as_float(((const unsigned*)(ws + WS_WMAX1))[n]), 1e-30f);
              if (lane == 0) SW1[n] = am * (1.0f / 127.0f);
              const float inv = 127.0f / am;
              QUANT_ROW(WIN + (size_t)n * LD4, ws + WS_W8 + (size_t)(n - ZI8) * LD8, inv); }
        }
        GRID_BAR(15);
        pg8::Gemm g{XN, WIN, MPAD, ZI8, DM, LD4}; pg8::Gemm g8{(const bf16*)(ws + WS_X8), (const bf16*)(ws + WS_W8), MPAD, NZ - ZI8, DM / 2, LD8 / 2};
        { pg8::StaticOrder S; S.init(MP, ZI8, F.G, (int)blockIdx.x); pg8::EpiBf E{Z, NZ, nullptr, 2, SSQ4};
          pg8::gemm_phase<pg8::EpiBf, pg8::StaticOrder, true, true>(F.lds + RING_OFF, g, S, E); }
        { pg8::StaticOrder S; S.init(MP, NZ - ZI8, F.G, (int)blockIdx.x); pg8::EpiBfI8 E{Z + ZI8, NZ, (const float*)(ws + WS_RS2), (const float*)(ws + WS_SW) + ZI8, 2};
          pg8::gemm_phase<pg8::EpiBfI8, pg8::StaticOrder, true, true, false, false, true>(F.lds + RING_OFF, g8, S, E); }
        { pg8::Gemm gs{XN, WIN, MPAD, NZ, 1024, LD4}; pg8::SplitOrder S2{MP / 256, NZ / 256, 4, 0, 0, 1024, 0, F.G, (int)blockIdx.x, 0}; pg8::EpiF32 E{(float*)(ws + WS_PS1), NZ, 1, 128};
          pg8::gemm_phase<pg8::EpiF32, pg8::SplitOrder, true, true, true>(F.lds + RING_OFF, gs, S2, E);
#ifdef PROBE_S1
          pg8::gemm_phase<pg8::EpiF32, pg8::SplitOrder, true, true, true>(F.lds + RING_OFF, gs, S2, E); pg8::gemm_phase<pg8::EpiF32, pg8::SplitOrder, true, true, true>(F.lds + RING_OFF, gs, S2, E);
#endif
        }
#if defined(PROBE_GEMM)
        {
            pg8::Gemm gq{XN, WIN, MPAD, DM, DM, LD4}; pg8::EpiBf Eq{MRG, LD4, nullptr, 2, nullptr};
#if PROBE_GEMM == 1
            pg8::StaticOrder Sq; Sq.init(MP, DM, F.G, (int)blockIdx.x); pg8::gemm_phase<pg8::EpiBf, pg8::StaticOrder, true, true>(F.lds + RING_OFF, gq, Sq, Eq);
#elif PROBE_GEMM == 2
            pg8::SameOrder Sq{2}; pg8::gemm_phase<pg8::EpiBf, pg8::SameOrder, true, true>(F.lds + RING_OFF, gq, Sq, Eq);
#else
            pg8::StaticOrder Sq; Sq.init(MP, DM, F.G, (int)blockIdx.x); pg8::gemm_phase<pg8::EpiBf, pg8::StaticOrder, true, true, true>(F.lds + RING_OFF, gq, Sq, Eq);
#endif
        }
#endif
        }
        if (BOTH(1)) GRID_BAR(1);
    }

    if (IN(2)) { REP(2) {
        PHASE_IDS;
        const float* w_conv = inptr(11); const float* state_conv = inptr(4); const float* w_alpha2 = inptr(9); const float* b_alpha = inptr(10);
        { const float* PS = (const float*)(ws + WS_PS1);
          for (int it = blockIdx.x * 512 + tid; it < MS * (NZ / 8); it += F.G * 512) { const int r = it / (NZ / 8), col = (it - r * (NZ / 8)) * 8, row = MP + r;
              const f32x4 q4 = *(const f32x4*)(SSQ4 + 4 * (size_t)row); const float rs0 = 1.0f / sqrtf(((q4[0] + q4[1]) + (q4[2] + q4[3])) * (1.0f / DM) + EPS);
              f32x4 a0 = (f32x4){0.f, 0.f, 0.f, 0.f}, a1 = a0;
#pragma unroll
              for (int sp = 0; sp < 4; ++sp) { const float* p = PS + ((size_t)sp * 128 + r) * NZ + col; a0 += *(const f32x4*)p; a1 += *(const f32x4*)(p + 4); }
              *(v4u*)(Z + (size_t)row * NZ + col) = pk8(a0 * rs0, a1 * rs0); } }
        for (int it = blockIdx.x * 512 + tid; it < (MP / 16) * (DC / 8); it += F.G * 512) {
            const int chunk = it >> 8, oct = it & 255, r0 = chunk * 16, t0 = r0 & (TSEQ - 1), c = oct * 8;
            f32x4 w0a = *(const f32x4*)(w_conv + c), w0b = *(const f32x4*)(w_conv + c + 4), w1a = *(const f32x4*)(w_conv + DC + c), w1b = *(const f32x4*)(w_conv + DC + c + 4),
                  w2a = *(const f32x4*)(w_conv + 2 * DC + c), w2b = *(const f32x4*)(w_conv + 2 * DC + c + 4);
            f32x4 um2a = (f32x4){0.f, 0.f, 0.f, 0.f}, um2b = um2a, um1a = um2a, um1b = um2a;
            if (t0 != 0) {
                const bf16* zr = Z + (size_t)(r0 - 2) * NZ + c; f32x4 ha, hb, ca, cb;
                unpk8(*(const v4u*)(zr + ZH), ha, hb); unpk8(*(const v4u*)(zr + ZC), ca, cb); um2a = ha * ca; um2b = hb * cb;
                unpk8(*(const v4u*)(zr + NZ + ZH), ha, hb); unpk8(*(const v4u*)(zr + NZ + ZC), ca, cb); um1a = ha * ca; um1b = hb * cb;
            }
#pragma unroll 1
            for (int i0 = 0; i0 < 16; i0 += 8) {
                v4u lh[8], lc_[8], lb[8];
#pragma unroll
                for (int i = 0; i < 8; ++i) { const bf16* zr = Z + (size_t)(r0 + i0 + i) * NZ + c; lh[i] = *(const v4u*)(zr + ZH); lc_[i] = *(const v4u*)(zr + ZC); lb[i] = *(const v4u*)(zr + ZB); }
#pragma unroll
                for (int i = 0; i < 8; ++i) { f32x4 ha, hb, ca, cb, ba, bb;
                    unpk8(lh[i], ha, hb); unpk8(lc_[i], ca, cb); unpk8(lb[i], ba, bb);
                    const f32x4 ua = ha * ca, ub = hb * cb;
                    const f32x4 oa = ba * (w0a * um2a + w1a * um1a + w2a * ua), ob = bb * (w0b * um2b + w1b * um1b + w2b * ub);
                    *(v4u*)(A2 + (size_t)(r0 + i0 + i) * LD2 + c) = pk8(oa, ob);
                    um2a = um1a; um2b = um1b; um1a = ua; um1b = ub; }
            }
            if (t0 + 16 == TSEQ) { const int b = r0 / TSEQ; float* o0 = out + O_CP + ((size_t)b * 2 + 0) * DC + c;
                *(f32x4*)(o0) = um2a; *(f32x4*)(o0 + 4) = um2b; *(f32x4*)(o0 + DC) = um1a; *(f32x4*)(o0 + DC + 4) = um1b; }
        }
        {
            LAS float* alr_s = (LAS float*)(F.lds + 0);
            LAS float* b_s = (LAS float*)(F.lds + 2048);
            LAS unsigned char* qt_s = F.lds + 34816;
            LAS unsigned char* kt_s = F.lds + 51712;
            LAS unsigned char* v_s = F.lds + 68608;
            for (int idx = blockIdx.x; idx < NBATCH * NCHUNK * NH; idx += F.G) {
                const int h = idx & 7, bc = idx >> 3, b = bc >> 6, c = bc & 63, row0 = b * TSEQ + c * CHUNK;
                unsigned char* pack = PACK + (size_t)idx * PACK_BYTES;
                v4u qv[2], kv[2], vv[2];
#pragma unroll
                for (int e = 0; e < 2; ++e) { const int ch = tid + 512 * e, t = ch >> 5, k8 = ch & 31; const bf16* zr = Z + (size_t)(row0 + t) * NZ + h * 256 + 8 * k8;
                    qv[e] = *(const v4u*)(zr + ZQ); kv[e] = *(const v4u*)(zr + ZK); vv[e] = *(const v4u*)(zr + ZV); }
                if (tid < 128) { const int rr = row0 + (tid >> 2); const f32x4 q4 = *(const f32x4*)(SSQ4 + 4 * (size_t)rr); const float rs0 = 1.0f / sqrtf(((q4[0] + q4[1]) + (q4[2] + q4[3])) * (1.0f / DM) + EPS);
                    const float* ap = ALR + (size_t)rr * 16 + 4 * (tid & 3);
                    *(LAS f32x4*)(alr_s + tid * 4) = ((*(const f32x4*)(ap) + *(const f32x4*)(ap + (size_t)MROWS * 16)) + (*(const f32x4*)(ap + (size_t)2 * MROWS * 16) + *(const f32x4*)(ap + (size_t)3 * MROWS * 16))) * rs0; }
                const int kk = 32 * wave + (lane & 31), th = lane >> 5;
                float w2r[16];
#pragma unroll
                for (int j = 0; j < 16; ++j) w2r[j] = w_alpha2[(size_t)j * (NH * DKH) + h * 256 + kk];
                const float bb = b_alpha[h * 256 + kk];
                __syncthreads();
                {
                    float bl[16]; float run = 0.f;
#pragma unroll
                    for (int i = 0; i < 16; ++i) { const int t = 16 * th + i; const LAS f32x4* ar = (const LAS f32x4*)(alr_s + t * 16);
                        const f32x4 a0 = ar[0], a1 = ar[1], a2 = ar[2], a3 = ar[3];
                        float x = bb;
                        x += a0[0] * w2r[0]; x += a0[1] * w2r[1]; x += a0[2] * w2r[2]; x += a0[3] * w2r[3];
                        x += a1[0] * w2r[4]; x += a1[1] * w2r[5]; x += a1[2] * w2r[6]; x += a1[3] * w2r[7];
                        x += a2[0] * w2r[8]; x += a2[1] * w2r[9]; x += a2[2] * w2r[10]; x += a2[3] * w2r[11];
                        x += a3[0] * w2r[12]; x += a3[1] * w2r[13]; x += a3[2] * w2r[14]; x += a3[3] * w2r[15];
                        run += logsig(x) * (1.0f / 16.0f); bl[i] = run; }
                    const float lo_tot = __shfl(run, lane & 31);
                    if (th) {
#pragma unroll
                        for (int i = 0; i < 16; ++i) bl[i] += lo_tot;
                    }
#pragma unroll
                    for (int i = 0; i < 16; ++i) b_s[(16 * th + i) * 256 + kk] = bl[i];
                }
                __syncthreads();
#pragma unroll
                for (int e = 0; e < 2; ++e) { const int ch = tid + 512 * e, t = ch >> 5, k8 = ch & 31;
                    const f32x4 b0 = *(const LAS f32x4*)(b_s + t * 256 + 8 * k8), b1 = *(const LAS f32x4*)(b_s + t * 256 + 8 * k8 + 4);
                    f32x4 e0, e1, i0, i1;
#pragma unroll
                    for (int q = 0; q < 4; ++q) { e0[q] = expf_fast(b0[q]); e1[q] = expf_fast(b1[q]); i0[q] = expf_fast(-b0[q]); i1[q] = expf_fast(-b1[q]); }
                    f32x4 q0, q1, k0, k1; unpk8(qv[e], q0, q1); unpk8(kv[e], k0, k1);
                    *(LAS v4u*)(qt_s + t * 528 + 16 * k8) = pk8(q0 * e0 * 0.0625f, q1 * e1 * 0.0625f);
                    *(LAS v4u*)(kt_s + t * 528 + 16 * k8) = pk8(k0 * i0, k1 * i1);
                    *(LAS v4u*)(v_s + t * 528 + 16 * k8) = vv[e];
                    if (t == 31) { *(f32x4*)(pack + DEC_OFF + 32 * k8) = e0; *(f32x4*)(pack + DEC_OFF + 32 * k8 + 16) = e1; } }
                __syncthreads();
                if (wave == 0) {
                    f32x16 acc;
#pragma unroll
                    for (int i = 0; i < 16; ++i) acc[i] = 0.f;
                    const int r = lane & 31, hh = lane >> 5;
#pragma unroll
                    for (int s = 0; s < 16; ++s) { const bf16x8 a = *(const LAS bf16x8*)(kt_s + r * 528 + (16 * s + 8 * hh) * 2), bq = *(const LAS bf16x8*)(qt_s + r * 528 + (16 * s + 8 * hh) * 2);
                        acc = MFMA32(a, bq, acc); }
#pragma unroll
                    for (int i = 0; i < 16; ++i) { const int srow = (i & 3) + 8 * (i >> 2) + 4 * hh; if (srow > r) acc[i] = 0.f; }
#pragma unroll
                    for (int st = 0; st < 2; ++st) { v4u w; w.x = pk2(acc[8 * st], acc[8 * st + 1]); w.y = pk2(acc[8 * st + 2], acc[8 * st + 3]); w.z = pk2(acc[8 * st + 4], acc[8 * st + 5]); w.w = pk2(acc[8 * st + 6], acc[8 * st + 7]);
                        *(v4u*)(pack + PF_OFF + (st * 64 + lane) * 16) = w; }
                }
#pragma unroll
                for (int e = 0; e < 2; ++e) { const int q = tid + 512 * e, ln = q & 63, r = ln & 31, hh = ln >> 5;
                    { const int sg = q >> 6;
                      const v2u lo2 = *(const LAS v2u*)(qt_s + r * 528 + (16 * sg + 4 * hh) * 2), hi2 = *(const LAS v2u*)(qt_s + r * 528 + (16 * sg + 8 + 4 * hh) * 2);
                      v4u w; w.x = lo2.x; w.y = lo2.y; w.z = hi2.x; w.w = hi2.y; *(v4u*)(pack + QTF_OFF + q * 16) = w; }
                    { const int i8 = q >> 7, st = (q >> 6) & 1; unsigned short kvv[8], vvv[8];
#pragma unroll
                      for (int j = 0; j < 8; ++j) { const int tt = 16 * st + 8 * (j >> 2) + 4 * hh + (j & 3);
                          kvv[j] = *(const LAS unsigned short*)(kt_s + tt * 528 + (32 * i8 + r) * 2); vvv[j] = *(const LAS unsigned short*)(v_s + tt * 528 + (32 * i8 + r) * 2); }
                      v4u wk, wv; wk.x = kvv[0] | ((unsigned)kvv[1] << 16); wk.y = kvv[2] | ((unsigned)kvv[3] << 16); wk.z = kvv[4] | ((unsigned)kvv[5] << 16); wk.w = kvv[6] | ((unsigned)kvv[7] << 16);
                      wv.x = vvv[0] | ((unsigned)vvv[1] << 16); wv.y = vvv[2] | ((unsigned)vvv[3] << 16); wv.z = vvv[4] | ((unsigned)vvv[5] << 16); wv.w = vvv[6] | ((unsigned)vvv[7] << 16);
                      *(v4u*)(pack + KTF_OFF + q * 16) = wk; *(v4u*)(pack + VF_OFF + q * 16) = wv; } }
                __syncthreads();
            }
        }
        }
        if (BOTH(2)) GRID_BAR(2);
    }

    if (IN(3)) { REP(3) {
        PHASE_IDS;
        const float* g_gla = inptr(13); const float* w_alpha2 = inptr(9); const float* b_alpha = inptr(10); const float* state_gla = inptr(5); const float* w_conv = inptr(11); const float* state_conv = inptr(4);
        if (blockIdx.x < 2 * NBATCH * NH) {
            const int bh = blockIdx.x >> 1, half = blockIdx.x & 1, b = bh >> 3, h = bh & 7, r = lane & 31, hh = lane >> 5;
            constexpr int CSLOT = 44032, C_VF = 32768, C_PF = 40960, C_DEC = 43008;
            const unsigned char* pk0 = PACK + (size_t)(b * NCHUNK * NH + h) * PACK_BYTES;
            float* Og = (float*)(ws + WS_O) + (size_t)(b * TSEQ) * (NH * DVH) + h * DVH + 128 * half;
            f32x16 S[8];
#ifdef DUP3A
            for (int rep3_ = 0; rep3_ < 2; ++rep3_) {
            VM_WAIT(); __syncthreads();
#else
            {
#endif
#pragma unroll
            for (int i = 0; i < 8; ++i)
#pragma unroll
                for (int e = 0; e < 16; ++e) S[i][e] = 0.f;
#define GLA_LOAD_PACK(cc, sl) do { const unsigned char* pn_ = pk0 + (size_t)(cc) * NH * PACK_BYTES; const int so_ = (sl) * CSLOT; \
        _Pragma("unroll") for (int k6_ = 0; k6_ < 6; ++k6_) { int p_ = wave + 8 * k6_; if (p_ >= 43) p_ = wave; const int pp_ = p_ < 32 ? p_ : (p_ < 40 ? 32 + 8 * half + (p_ - 32) : 48 + (p_ - 40)); \
            __builtin_amdgcn_global_load_lds((const unsigned*)(pn_ + pp_ * 1024 + lane * 16), (LAS unsigned*)(F.lds + so_ + p_ * 1024), 16, 0, 0); } } while (0)
            GLA_LOAD_PACK(0, 0); GLA_LOAD_PACK(1, 1);
            int sl = 0;
            for (int c = 0; c < NCHUNK; ++c) {
                if (c == NCHUNK - 1) asm volatile("s_waitcnt vmcnt(0)" ::: "memory");
                else if (wave >= 4 || c == 0) asm volatile("s_waitcnt vmcnt(6)" ::: "memory");
                else if (c == 1) asm volatile("s_waitcnt vmcnt(22)" ::: "memory");
                else asm volatile("s_waitcnt vmcnt(38)" ::: "memory");
                LDS_WAIT(); __builtin_amdgcn_s_barrier(); asm volatile("" ::: "memory");
                const int sl2 = sl == 0 ? 2 : sl - 1;
                if (c + 2 < NCHUNK) GLA_LOAD_PACK(c + 2, sl2);
                if (wave < 4) {
                    const LAS unsigned char* sb = F.lds + sl * CSLOT;
                    bf16x8 Vf[2], Pf[2];
#pragma unroll
                    for (int st = 0; st < 2; ++st) { Vf[st] = *(const LAS bf16x8*)(sb + C_VF + ((wave * 2 + st) * 64 + lane) * 16); Pf[st] = *(const LAS bf16x8*)(sb + C_PF + (st * 64 + lane) * 16); }
                    f32x16 o;
#pragma unroll
                    for (int e = 0; e < 16; ++e) o[e] = 0.f;
                    o = MFMA32(Pf[0], Vf[0], o); o = MFMA32(Pf[1], Vf[1], o);
#pragma unroll
                    for (int i = 0; i < 8; ++i)
#pragma unroll
                        for (int sI = 0; sI < 2; ++sI) { const bf16x8 a = *(const LAS bf16x8*)(sb + QTF_OFF + ((2 * i + sI) * 64 + lane) * 16);
                            v4u w; w.x = pk2(S[i][8 * sI], S[i][8 * sI + 1]); w.y = pk2(S[i][8 * sI + 2], S[i][8 * sI + 3]); w.z = pk2(S[i][8 * sI + 4], S[i][8 * sI + 5]); w.w = pk2(S[i][8 * sI + 6], S[i][8 * sI + 7]);
                            o = MFMA32(a, __builtin_bit_cast(bf16x8, w), o); }
#pragma unroll
                    for (int i = 0; i < 8; ++i) {
#pragma unroll
                        for (int st = 0; st < 2; ++st) { const bf16x8 a = *(const LAS bf16x8*)(sb + KTF_OFF + ((2 * i + st) * 64 + lane) * 16); S[i] = MFMA32(a, Vf[st], S[i]); }
#pragma unroll
                        for (int g = 0; g < 4; ++g) { const f32x4 d = *(const LAS f32x4*)(sb + C_DEC + (32 * i + 8 * g + 4 * hh) * 4);
                            S[i][4 * g] *= d[0]; S[i][4 * g + 1] *= d[1]; S[i][4 * g + 2] *= d[2]; S[i][4 * g + 3] *= d[3]; }
                        asm volatile("" : "+v"(S[i]));
                    }
                    char* ob = (char*)(Og + (size_t)(c * CHUNK + 4 * hh) * (NH * DVH) + 32 * wave + r);
#pragma unroll
                    for (int i = 0; i < 16; ++i) *(float*)(ob + (size_t)((i & 3) + 8 * (i >> 2)) * (NH * DVH * 4)) = o[i];
                }
                sl = sl == 2 ? 0 : sl + 1;
            }
            }
            if (wave < 4) {
                float* so = out + O_GP + (size_t)bh * DKH * DVH + 128 * half + 32 * wave + r + 4 * hh * DVH;
#pragma unroll
                for (int i = 0; i < 8; ++i) {
#pragma unroll
                    for (int e = 0; e < 16; ++e) so[(unsigned)((32 * i + (e & 3) + 8 * (e >> 2)) * DVH)] = S[i][e];
                    asm volatile("" ::: "memory"); }
            }
            VM_WAIT(); __syncthreads();
        } else {
#ifdef DUP3B
            for (int rep3_ = 0; rep3_ < 2; ++rep3_) {
#else
            {
#endif
            for (int it = (blockIdx.x - 2 * NBATCH * NH) * 512 + tid; it < MS * (DC / 8); it += (F.G - 2 * NBATCH * NH) * 512) {
            const int b = it >> 8, oct = it & 255, c = oct * 8, row = MP + b;
            f32x4 w0a = *(const f32x4*)(w_conv + c), w0b = *(const f32x4*)(w_conv + c + 4), w1a = *(const f32x4*)(w_conv + DC + c), w1b = *(const f32x4*)(w_conv + DC + c + 4),
                  w2a = *(const f32x4*)(w_conv + 2 * DC + c), w2b = *(const f32x4*)(w_conv + 2 * DC + c + 4);
            const float* sc = state_conv + (size_t)b * 2 * DC + c;
            const f32x4 um2a = *(const f32x4*)(sc), um2b = *(const f32x4*)(sc + 4), um1a = *(const f32x4*)(sc + DC), um1b = *(const f32x4*)(sc + DC + 4);
            const bf16* zr = Z + (size_t)row * NZ + c; f32x4 ha, hb, ca, cb, ba, bb;
            unpk8(*(const v4u*)(zr + ZH), ha, hb); unpk8(*(const v4u*)(zr + ZC), ca, cb); unpk8(*(const v4u*)(zr + ZB), ba, bb);
            const f32x4 ua = ha * ca, ub = hb * cb;
            const f32x4 oa = ba * (w0a * um2a + w1a * um1a + w2a * ua), ob = bb * (w0b * um2b + w1b * um1b + w2b * ub);
            *(v4u*)(A2 + (size_t)row * LD2 + c) = pk8(oa, ob);
            float* o0 = out + O_CS + (size_t)b * 2 * DC + c;
            *(f32x4*)(o0) = um1a; *(f32x4*)(o0 + 4) = um1b; *(f32x4*)(o0 + DC) = ua; *(f32x4*)(o0 + DC + 4) = ub;
        }
            LAS float* ws_ = (LAS float*)(F.lds + wave * 768);
            LAS float* part = (LAS float*)(F.lds + 8192);
            const int nbs = F.G - 2 * NBATCH * NH;
            for (int pr = blockIdx.x - 2 * NBATCH * NH; pr < MS * NH / 2; pr += nbs) {
                const int u = 2 * pr + (wave >> 2), b = u >> 3, h = u & 7, row = MP + b, kk0 = 64 * (wave & 3), kk = kk0 + lane;
                {
                    f32x4 al[4];
#pragma unroll
                    for (int q = 0; q < 4; ++q) { const float* ap = ALR + (size_t)row * 16 + 4 * q; al[q] = (*(const f32x4*)(ap) + *(const f32x4*)(ap + (size_t)MROWS * 16)) + (*(const f32x4*)(ap + (size_t)2 * MROWS * 16) + *(const f32x4*)(ap + (size_t)3 * MROWS * 16)); }
                    const f32x4 q4 = *(const f32x4*)(SSQ4 + 4 * (size_t)row); const float rs0 = 1.0f / sqrtf(((q4[0] + q4[1]) + (q4[2] + q4[3])) * (1.0f / DM) + EPS);
                    float x = 0.f;
#pragma unroll
                    for (int jj = 0; jj < 16; ++jj) x += al[jj >> 2][jj & 3] * w_alpha2[(size_t)jj * (NH * DKH) + h * 256 + kk];
                    x = x * rs0 + b_alpha[h * 256 + kk];
                    ws_[lane] = expf_fast(logsig(x) * (1.0f / 16.0f));
                    ws_[64 + lane] = __uint_as_float((unsigned)Z[(size_t)row * NZ + ZK + h * 256 + kk] << 16);
                    ws_[128 + lane] = __uint_as_float((unsigned)Z[(size_t)row * NZ + ZQ + h * 256 + kk] << 16) * 0.0625f;
                }
                LDS_WAIT(); asm volatile("" ::: "memory");
                f32x4 vv; { const v2u w = *(const v2u*)(Z + (size_t)row * NZ + ZV + h * 256 + 4 * lane); vv = (f32x4){bflo(w.x), bfhi(w.x), bflo(w.y), bfhi(w.y)}; }
                const float* s0 = state_gla + ((size_t)(b * NH + h) * DKH + kk0) * DVH + 4 * lane; float* s1 = out + O_GS + ((size_t)(b * NH + h) * DKH + kk0) * DVH + 4 * lane;
                f32x4 o = (f32x4){0.f, 0.f, 0.f, 0.f};
                f32x4 cbuf[16], nbuf[16];
#pragma unroll
                for (int i = 0; i < 16; ++i) cbuf[i] = *(const f32x4*)(s0 + (size_t)i * DVH);
#pragma unroll
                for (int k0 = 0; k0 < 64; k0 += 16) {
                    if (k0 + 16 < 64) {
#pragma unroll
                        for (int i = 0; i < 16; ++i) nbuf[i] = *(const f32x4*)(s0 + (size_t)(k0 + 16 + i) * DVH);
                    }
#pragma unroll
                    for (int i = 0; i < 16; ++i) { const float a = ws_[k0 + i], kf = ws_[64 + k0 + i], qf = ws_[128 + k0 + i];
                        const f32x4 sn = cbuf[i] * a + vv * kf; *(f32x4*)(s1 + (size_t)(k0 + i) * DVH) = sn; o += sn * qf; }
#pragma unroll
                    for (int i = 0; i < 16; ++i) cbuf[i] = nbuf[i];
                }
                *(LAS f32x4*)(part + wave * 256 + 4 * lane) = o;
                __syncthreads();
                if ((wave & 3) == 0) {
                    const LAS float* pp_ = part + wave * 256 + 4 * lane;
                    const f32x4 ot = (*(const LAS f32x4*)(pp_) + *(const LAS f32x4*)(pp_ + 256)) + (*(const LAS f32x4*)(pp_ + 512) + *(const LAS f32x4*)(pp_ + 768));
                    const float tot = wave_sum((ot[0] * ot[0] + ot[1] * ot[1]) + (ot[2] * ot[2] + ot[3] * ot[3]));
                    const float rstd = 1.0f / sqrtf(tot * (1.0f / DVH) + EPS);
                    const f32x4 gg = *(const f32x4*)(g_gla + 4 * lane);
                    const v2u rw = *(const v2u*)(Z + (size_t)row * NZ + ZR + h * 256 + 4 * lane);
                    v2u ow; ow.x = pk2(ot[0] * rstd * gg[0] * silu(bflo(rw.x)), ot[1] * rstd * gg[1] * silu(bfhi(rw.x))); ow.y = pk2(ot[2] * rstd * gg[2] * silu(bflo(rw.y)), ot[3] * rstd * gg[3] * silu(bfhi(rw.y)));
                    *(v2u*)(B2 + (size_t)row * LD2 + h * 256 + 4 * lane) = ow;
                }
                __syncthreads();
            }
            { const int sgw = ((int)blockIdx.x - 2 * NBATCH * NH) * NWAVES + wave, snw = (F.G - 2 * NBATCH * NH) * NWAVES;
          for (int n = sgw; n < DM; n += snw) { const bf16* wr_ = WOB + (size_t)n * LD2; f32x4 wv[8]; float am = 0.f;
#pragma unroll
              for (int ch = 0; ch < 8; ++ch) { const v2u w2 = *(const v2u*)(wr_ + 256 * ch + 4 * lane); f32x4 a = (f32x4){bflo(w2.x), bfhi(w2.x), bflo(w2.y), bfhi(w2.y)}; fwht32(a, lane); wv[ch] = a; }
#pragma unroll
              for (int st = 1; st < 8; st <<= 1)
#pragma unroll
                  for (int ch = 0; ch < 8; ++ch) if (!(ch & st)) { const f32x4 t = wv[ch] + wv[ch | st], u = wv[ch] - wv[ch | st]; wv[ch] = t; wv[ch | st] = u; }
#pragma unroll
              for (int ch = 0; ch < 8; ++ch) am = fmaxf(am, fmaxf(fmaxf(fabsf(wv[ch][0]), fabsf(wv[ch][1])), fmaxf(fabsf(wv[ch][2]), fabsf(wv[ch][3]))));
#pragma unroll
              for (int sh = 1; sh < 64; sh <<= 1) am = fmaxf(am, __shfl_xor(am, sh));
              am = fmaxf(am, 1e-30f); const float inv = 127.0f / am;
              if (lane == 0) ((float*)(ws + WS_SWB))[n] = am * (1.0f / 127.0f);
#pragma unroll
              for (int ch = 0; ch < 8; ++ch) { unsigned q_[4];
#pragma unroll
                  for (int e_ = 0; e_ < 4; ++e_) q_[e_] = __float_as_uint(fmaf(wv[ch][e_], inv, 12582912.0f));
                  *(unsigned*)(ws + WS_WOB8 + (size_t)n * LDB8 + 256 * ch + 4 * lane) = __builtin_amdgcn_perm(q_[1], q_[0], 0x0c0c0400u) | __builtin_amdgcn_perm(q_[3], q_[2], 0x04000c0cu); } }
        for (int n = sgw; n < DM; n += snw) { const float am = fmaxf(__uint_as_float(((const unsigned*)(ws + WS_WMAXP))[n]), 1e-30f);
            if (lane == 0) ((float*)(ws + WS_SWP))[n] = am * (1.0f / 127.0f);
            const float inv = 127.0f / am;
            QUANT_ROW(WPG + (size_t)n * LD4, ws + WS_WPGI + (size_t)n * LD8, inv); }
            }
            }
        }
        }
        if (BOTH(3)) GRID_BAR(3);
    }

    if (IN(4)) { REP(4) {
        PHASE_IDS;
        const float* g_gla = inptr(13);
        const float* Ob = (const float*)(ws + WS_O);
        const f32x4 gg = *(const f32x4*)(g_gla + 4 * lane);
        for (int it0 = gw * 8; it0 < MP * NH; it0 += NGW * 8) {
            f32x4 o[8]; v2u rw[8]; const int row = it0 >> 3;
#pragma unroll
            for (int q = 0; q < 8; ++q) { o[q] = *(const f32x4*)(Ob + (size_t)row * (NH * DVH) + q * DVH + 4 * lane); rw[q] = *(const v2u*)(Z + (size_t)row * NZ + ZR + q * 256 + 4 * lane); }
            float am = 0.f;
#pragma unroll
            for (int q = 0; q < 8; ++q) {
                const float tot = wave_sum((o[q][0] * o[q][0] + o[q][1] * o[q][1]) + (o[q][2] * o[q][2] + o[q][3] * o[q][3]));
                const float rstd = 1.0f / sqrtf(tot * (1.0f / DVH) + EPS) * (1.0f / 256.0f);
                f32x4 y = (f32x4){o[q][0] * rstd * gg[0] * silu(bflo(rw[q].x)), o[q][1] * rstd * gg[1] * silu(bfhi(rw[q].x)), o[q][2] * rstd * gg[2] * silu(bflo(rw[q].y)), o[q][3] * rstd * gg[3] * silu(bfhi(rw[q].y))};
                fwht32(y, lane); o[q] = y; }
#pragma unroll
            for (int st = 1; st < 8; st <<= 1)
#pragma unroll
                for (int q = 0; q < 8; ++q) if (!(q & st)) { const f32x4 t = o[q] + o[q | st], u = o[q] - o[q | st]; o[q] = t; o[q | st] = u; }
#pragma unroll
            for (int q = 0; q < 8; ++q) am = fmaxf(am, fmaxf(fmaxf(fabsf(o[q][0]), fabsf(o[q][1])), fmaxf(fabsf(o[q][2]), fabsf(o[q][3]))));
#pragma unroll
            for (int sh = 1; sh < 64; sh <<= 1) am = fmaxf(am, __shfl_xor(am, sh));
            am = fmaxf(am, 1e-30f); const float inv = 127.0f / am;
            if (lane == 0) ((float*)(ws + WS_RS2))[row] = am * (1.0f / 127.0f);
#pragma unroll
            for (int q = 0; q < 8; ++q) { unsigned q_[4];
#pragma unroll
                for (int e_ = 0; e_ < 4; ++e_) q_[e_] = __float_as_uint(fmaf(o[q][e_], inv, 12582912.0f));
                *(unsigned*)(ws + WS_B8 + (size_t)row * LDB8 + q * 256 + 4 * lane) = __builtin_amdgcn_perm(q_[1], q_[0], 0x0c0c0400u) | __builtin_amdgcn_perm(q_[3], q_[2], 0x04000c0cu); }
        }
        }
        if (BOTH(4)) GRID_BAR(4);
    }

    if (IN(5)) { REP(5) {
        pg8::StaticOrder S; S.init(MP, DM, F.G, (int)blockIdx.x);
        pg8::Gemm ga{A2, WOA, MPAD, DM, DC, LD2}, gb{B2, WOB, MPAD, DM, DC, LD2};
        { pg8::EpiGate1 E{Z + ZGA, NZ, MRG, LD4, 2}; pg8::gemm_phase<pg8::EpiGate1, pg8::StaticOrder, true, true>(F.lds + RING_OFF, ga, S, E); }
        { pg8::Gemm gb8{(const bf16*)(ws + WS_B8), (const bf16*)(ws + WS_WOB8), MPAD, DM, DC / 2, LDB8 / 2};
          pg8::EpiGate2 E{Z + ZGB, NZ, MRG, LD4, 2, (const float*)(ws + WS_RS2), (const float*)(ws + WS_SWB)}; pg8::gemm_phase<pg8::EpiGate2, pg8::StaticOrder, true, true, false, false, true>(F.lds + RING_OFF, gb8, S, E); }
        { pg8::Gemm gs{A2, WOA, MPAD, DM, 256, LD2}; pg8::SplitOrder S2{MP / 256, DM / 256, 8, 0, 0, 256, 0, (DM / 256) * (8), (int)blockIdx.x, 0}; pg8::EpiF32 E{(float*)(ws + WS_PS4), DM, 1, 128};
          pg8::gemm_phase<pg8::EpiF32, pg8::SplitOrder, true, true, true>(F.lds + RING_OFF, gs, S2, E); }
        { pg8::Gemm gs{B2, WOB, MPAD, DM, 256, LD2}; pg8::SplitOrder S2{MP / 256, DM / 256, 8, 0, 0, 256, 128, (DM / 256) * (8), (int)blockIdx.x, 0}; pg8::EpiF32 E{(float*)(ws + WS_PS4) + (size_t)8 * 128 * DM, DM, 1, 128};
          pg8::gemm_phase<pg8::EpiF32, pg8::SplitOrder, true, true, true>(F.lds + RING_OFF, gs, S2, E); }
        }
        if (BOTH(5)) GRID_BAR(5);
    }

    if (IN(6)) { REP(6) {
        PHASE_IDS;
        const float* PA = (const float*)(ws + WS_PS4); const float* PB = PA + (size_t)8 * 128 * DM;
        for (int it = gw; it < MS * 8; it += NGW) { const int r = it >> 3, col = (it & 7) * 512 + lane * 8, row = MP + r;
            f32x4 a0 = (f32x4){0.f, 0.f, 0.f, 0.f}, a1 = a0, b0 = a0, b1 = a0;
#pragma unroll
            for (int sp = 0; sp < 8; ++sp) { const size_t o = ((size_t)sp * 128 + r) * DM + col;
                a0 += *(const f32x4*)(PA + o); a1 += *(const f32x4*)(PA + o + 4); b0 += *(const f32x4*)(PB + o); b1 += *(const f32x4*)(PB + o + 4); }
            f32x4 ga0, ga1, gb0, gb1; unpk8(*(const v4u*)(Z + (size_t)row * NZ + ZGA + col), ga0, ga1); unpk8(*(const v4u*)(Z + (size_t)row * NZ + ZGB + col), gb0, gb1);
            f32x4 m0, m1;
#pragma unroll
            for (int q = 0; q < 4; ++q) { m0[q] = sigm(ga0[q]) * a0[q] + sigm(gb0[q]) * b0[q]; m1[q] = sigm(ga1[q]) * a1[q] + sigm(gb1[q]) * b1[q]; }
            *(v4u*)(MRG + (size_t)row * LD4 + col) = pk8(m0, m1); }
        }
        if (BOTH(6)) GRID_BAR(6);
    }

    if (IN(7)) { REP(7) {
        const float* x_prompt = inptr(0); const float* x_sample = inptr(1);
        pg8::Gemm g{MRG, WMIX, MPAD, DM, DM, LD4};
        { pg8::StaticOrder S; S.init(MP, DM, F.G, (int)blockIdx.x); pg8::EpiRes<0> E{x_prompt, x_sample, out + O_Y, XN, LD4, PART, 2, nullptr, (float*)(ws + WS_PARTM), nullptr, nullptr};
          pg8::gemm_phase<pg8::EpiRes<0>, pg8::StaticOrder, true, true>(F.lds + RING_OFF, g, S, E); }
        { pg8::Gemm gs{MRG, WMIX, MPAD, DM, 256, LD4}; pg8::SplitOrder S2{MP / 256, DM / 256, 16, 0, 0, 256, 0, (DM / 256) * (16), (int)blockIdx.x, 0}; pg8::EpiF32 E{(float*)(ws + WS_PS6), DM, 1, 128};
          pg8::gemm_phase<pg8::EpiF32, pg8::SplitOrder, true, true, true>(F.lds + RING_OFF, gs, S2, E); }
        }
        if (BOTH(7)) GRID_BAR(7);
    }
    if (IN(8)) { REP(8) {
        PHASE_IDS;
        const float* x_sample = inptr(1);
        float* RS2 = (float*)(ws + WS_RS2); float* SW = (float*)(ws + WS_SW); const float* PARTM = (const float*)(ws + WS_PARTM);
        for (int row = gw; row < MPAD; row += NGW) {
            if (row < MP) { const float s = wave_sum(PART[(size_t)row * 64 + lane]); float am = PARTM[(size_t)row * 64 + lane];
#pragma unroll
                for (int o = 1; o < 64; o <<= 1) am = fmaxf(am, __shfl_xor(am, o));
                am = fmaxf(am, 1e-30f); const float rstd = 1.0f / sqrtf(s * (1.0f / DM) + EPS);
                if (lane == 0) { RSTD[row] = rstd; RS2[row] = rstd * am * (1.0f / 127.0f); }
                const float inv = 127.0f / am;
                QUANT_ROW(XN + (size_t)row * LD4, ws + WS_H1Q + (size_t)row * LD8, inv);
                const int t = row & (TSEQ - 1);
                if (t >= TSEQ - 2) { bf16* dp = XN + (size_t)(MROWS + 2 * (row / TSEQ) + (t - (TSEQ - 2))) * LD4; const bf16* sp = XN + (size_t)row * LD4;
#pragma unroll
                    for (int j = 0; j < 8; ++j) *(v4u*)(dp + 512 * j + 8 * lane) = *(const v4u*)(sp + 512 * j + 8 * lane); } }
            else if (row >= MROWS) { if (lane == 0) RSTD[row] = 0.f; }
        }
        for (int n = gw; n < NUP; n += NGW) { const float am = fmaxf(__uint_as_float(((const unsigned*)(ws + WS_WMAX))[n]), 1e-30f);
            if (lane == 0) SW[n] = am * (1.0f / 127.0f);
            const float inv = 127.0f / am;
            QUANT_ROW(WUP + (size_t)n * LD4, ws + WS_WU8 + (size_t)n * LD8, inv); }
        for (int n = gw; n < DM; n += NGW) { const bf16* wr_ = WDN + (size_t)n * LDF; float am = 0.f;
            v4u raw[22];
#pragma unroll
            for (int bp = 0; bp < 22; ++bp) { const int k0 = 512 * bp + 8 * lane; raw[bp] = (v4u){0u, 0u, 0u, 0u}; if (k0 < DFF) raw[bp] = *(const v4u*)(wr_ + k0); }
#pragma unroll
            for (int bp = 0; bp < 22; ++bp) { f32x4 a, b; unpk8(raw[bp], a, b); fwht64(a, b, lane);
                am = fmaxf(am, fmaxf(fmaxf(fmaxf(fabsf(a[0]), fabsf(a[1])), fmaxf(fabsf(a[2]), fabsf(a[3]))), fmaxf(fmaxf(fabsf(b[0]), fabsf(b[1])), fmaxf(fabsf(b[2]), fabsf(b[3]))))); }
#pragma unroll
            for (int o = 1; o < 64; o <<= 1) am = fmaxf(am, __shfl_xor(am, o));
            am = fmaxf(am, 1e-30f);
            if (lane == 0) ((float*)(ws + WS_SWD))[n] = am * (1.0f / 127.0f);
            const float inv = 127.0f / am; unsigned char* q8 = ws + WS_WD8 + (size_t)n * LDA8;
#pragma unroll
            for (int bp = 0; bp < 22; ++bp) { const int k0 = 512 * bp + 8 * lane; f32x4 a, b; unpk8(raw[bp], a, b); fwht64(a, b, lane);
                unsigned q_[8];
#pragma unroll
                for (int e_ = 0; e_ < 4; ++e_) { q_[e_] = __float_as_uint(fmaf(a[e_], inv, 12582912.0f)); q_[4 + e_] = __float_as_uint(fmaf(b[e_], inv, 12582912.0f)); }
                v2u o_; o_.x = __builtin_amdgcn_perm(q_[1], q_[0], 0x0c0c0400u) | __builtin_amdgcn_perm(q_[3], q_[2], 0x04000c0cu); o_.y = __builtin_amdgcn_perm(q_[5], q_[4], 0x0c0c0400u) | __builtin_amdgcn_perm(q_[7], q_[6], 0x04000c0cu);
                if (k0 < DFF) *(v2u*)(q8 + k0) = o_; } }
        { LAS float* red = (LAS float*)(F.lds);
          for (int r = blockIdx.x; r < MS; r += F.G) { const int row = MP + r; const float* PS = (const float*)(ws + WS_PS6) + (size_t)r * DM; float ss = 0.f;
#pragma unroll
              for (int j2 = 0; j2 < 2; ++j2) { const int col = 512 * wave + 256 * j2 + 4 * lane; f32x4 h = *(const f32x4*)(x_sample + (size_t)r * DM + col);
#pragma unroll
                  for (int sp = 0; sp < 16; ++sp) h += *(const f32x4*)(PS + (size_t)sp * 128 * DM + col);
                  ss += (h[0] * h[0] + h[1] * h[1]) + (h[2] * h[2] + h[3] * h[3]);
                  *(f32x4*)(out + O_Y + (size_t)row * DM + col) = h;
                  v2u o; o.x = pk2(h[0], h[1]); o.y = pk2(h[2], h[3]); *(v2u*)(XN + (size_t)row * LD4 + col) = o; }
              ss = wave_sum(ss); if (lane == 0) red[wave] = ss; __syncthreads();
              if (tid == 0) { const float tot = ((red[0] + red[1]) + (red[2] + red[3])) + ((red[4] + red[5]) + (red[6] + red[7])); RSTD[row] = 1.0f / sqrtf(tot * (1.0f / DM) + EPS); }
              __syncthreads(); } }
        }
        if (BOTH(8)) GRID_BAR(8);
    }
    if (IN(9)) { REP(9) {
        pg8::Gemm g{(const bf16*)(ws + WS_H1Q), (const bf16*)(ws + WS_WU8), MPAD, NUP, DM / 2, LD8 / 2};
        { pg8::StaticOrder S; S.init(MP, NUP, F.G, (int)blockIdx.x); pg8::EpiBfI8 E{UP, NUP, (const float*)(ws + WS_RS2), (const float*)(ws + WS_SW), 2};
          pg8::gemm_phase<pg8::EpiBfI8, pg8::StaticOrder, true, true, false, false, true>(F.lds + RING_OFF, g, S, E); }
        { pg8::Gemm gs{XN, WUP, MPAD, NUP, 1024, LD4}; pg8::SplitOrder S2{MP / 256, NUP / 256, 4, 0, 0, 1024, 0, F.G, (int)blockIdx.x, (F.G == 256) ? 2 : 0}; pg8::EpiF32S E{(float*)(ws + WS_PS9), NUP};
          pg8::gemm_phase<pg8::EpiF32S, pg8::SplitOrder, true, true, false>(F.lds + RING_OFF, gs, S2, E); }
        }
        if (BOTH(9)) GRID_BAR(9);
    }
    if (IN(10)) { REP(10) {
        PHASE_IDS;
        const float* w_ffn_conv = inptr(18); const float* state_ffn = inptr(6);
        constexpr int NOCT = DFF / 8;
        for (int rb = blockIdx.x; rb < MP / 32; rb += F.G) {
            const int r0 = rb * 32, t0 = r0 & (TSEQ - 1);
            LAS unsigned* rowmax = (LAS unsigned*)(F.lds);
            __syncthreads(); if (tid < 32) rowmax[tid] = 0u; __syncthreads();
            const int rot = 32 * ((rb * 5) % 43);
            for (int oct0 = tid; oct0 < NOCT; oct0 += 512) {
                int oct = oct0 + rot; if (oct >= NOCT) oct -= NOCT;
                const int c = oct * 8;
                f32x4 wg[3][2], wv[3][2];
#pragma unroll
                for (int j = 0; j < 3; ++j) { wg[j][0] = *(const f32x4*)(w_ffn_conv + (size_t)j * NUP + c); wg[j][1] = *(const f32x4*)(w_ffn_conv + (size_t)j * NUP + c + 4);
                    wv[j][0] = *(const f32x4*)(w_ffn_conv + (size_t)j * NUP + DFF + c); wv[j][1] = *(const f32x4*)(w_ffn_conv + (size_t)j * NUP + DFF + c + 4); }
                f32x4 g2a = (f32x4){0.f, 0.f, 0.f, 0.f}, g2b = g2a, g1a = g2a, g1b = g2a, v2a = g2a, v2b = g2a, v1a = g2a, v1b = g2a;
                const bf16* ub = UP + (size_t)r0 * NUP + c;
                v4u lg[2][4], lv[2][4];
#pragma unroll
                for (int i = 0; i < 4; ++i) { lg[0][i] = *(const v4u*)(ub + (size_t)i * NUP); lv[0][i] = *(const v4u*)(ub + (size_t)i * NUP + DFF); }
                if (t0 != 0) { const bf16* ur = ub - 2 * (size_t)NUP;
                    unpk8(*(const v4u*)(ur), g2a, g2b); unpk8(*(const v4u*)(ur + DFF), v2a, v2b); unpk8(*(const v4u*)(ur + NUP), g1a, g1b); unpk8(*(const v4u*)(ur + NUP + DFF), v1a, v1b); }
#pragma unroll
                for (int k = 0; k < 8; ++k) {
                    if (k + 1 < 8) {
#pragma unroll
                        for (int i = 0; i < 4; ++i) { lg[(k + 1) & 1][i] = *(const v4u*)(ub + (size_t)(4 * (k + 1) + i) * NUP); lv[(k + 1) & 1][i] = *(const v4u*)(ub + (size_t)(4 * (k + 1) + i) * NUP + DFF); }
                    }
#pragma unroll
                    for (int i = 0; i < 4; ++i) { f32x4 ga, gb, va, vb;
                        unpk8(lg[k & 1][i], ga, gb); unpk8(lv[k & 1][i], va, vb);
                        const f32x4 cga = wg[0][0] * g2a + wg[1][0] * g1a + wg[2][0] * ga, cgb = wg[0][1] * g2b + wg[1][1] * g1b + wg[2][1] * gb;
                        const f32x4 cva = wv[0][0] * v2a + wv[1][0] * v1a + wv[2][0] * va, cvb = wv[0][1] * v2b + wv[1][1] * v1b + wv[2][1] * vb;
                        f32x4 oa, ob;
#pragma unroll
                        for (int q = 0; q < 4; ++q) { oa[q] = silu(cga[q]) * cva[q]; ob[q] = silu(cgb[q]) * cvb[q]; }
                        fwht64(oa, ob, lane);
                        oa = oa * 0.015625f; ob = ob * 0.015625f;
                        *(v4u*)(UPA + (size_t)(r0 + 4 * k + i) * LDF + c) = pk8(oa, ob);
                        { float mx = fmaxf(fmaxf(fmaxf(fabsf(oa[0]), fabsf(oa[1])), fmaxf(fabsf(oa[2]), fabsf(oa[3]))), fmaxf(fmaxf(fabsf(ob[0]), fabsf(ob[1])), fmaxf(fabsf(ob[2]), fabsf(ob[3]))));
                          mx = fmaxf(mx, __int_as_float(__builtin_amdgcn_mov_dpp(__float_as_int(mx), 0xB1, 0xf, 0xf, true))); mx = fmaxf(mx, __int_as_float(__builtin_amdgcn_mov_dpp(__float_as_int(mx), 0x4E, 0xf, 0xf, true)));
                          mx = fmaxf(mx, __int_as_float(__builtin_amdgcn_mov_dpp(__float_as_int(mx), 0x124, 0xf, 0xf, true))); mx = fmaxf(mx, __int_as_float(__builtin_amdgcn_mov_dpp(__float_as_int(mx), 0x128, 0xf, 0xf, true)));
                          if ((lane & 15) == 0) __hip_atomic_fetch_max(rowmax + 4 * k + i, __float_as_uint(mx), __ATOMIC_RELAXED, __HIP_MEMORY_SCOPE_WORKGROUP); }
                        g2a = g1a; g2b = g1b; g1a = ga; g1b = gb; v2a = v1a; v2b = v1b; v1a = va; v1b = vb; }
                }
                if (t0 + 32 == TSEQ) { const int b = r0 / TSEQ;
#pragma unroll
                    for (int j = 0; j < 2; ++j) { f32x4 ga = (f32x4){0.f, 0.f, 0.f, 0.f}, gb = ga, va = ga, vb = ga; const float rsr = RSTD[r0 + 30 + j];
#pragma unroll
                        for (int sp = 0; sp < 4; ++sp) { const float* p = (const float*)(ws + WS_PS9) + ((size_t)sp * 144 + 128 + 2 * b + j) * NUP + c; ga += *(const f32x4*)p; gb += *(const f32x4*)(p + 4); va += *(const f32x4*)(p + DFF); vb += *(const f32x4*)(p + DFF + 4); }
                        float* o0 = out + O_FP + ((size_t)b * 2 + j) * NUP + c;
                        *(f32x4*)(o0) = ga * rsr; *(f32x4*)(o0 + 4) = gb * rsr; *(f32x4*)(o0 + DFF) = va * rsr; *(f32x4*)(o0 + DFF + 4) = vb * rsr; } }
            }
            VM_WAIT(); __syncthreads();
            if (tid < 32) ((float*)(ws + WS_RS2))[r0 + tid] = fmaxf(__uint_as_float(rowmax[tid]) * 1.004f, 1e-30f) * (1.0f / 127.0f);
            for (int oct0 = tid; oct0 < NOCT; oct0 += 512) {
                int oct = oct0 + rot; if (oct >= NOCT) oct -= NOCT;
                const int c = oct * 8;
#pragma unroll 1
                for (int i0 = 0; i0 < 32; i0 += 8) { v4u w8[8];
#pragma unroll
                    for (int i = 0; i < 8; ++i) w8[i] = *(const v4u*)(UPA + (size_t)(r0 + i0 + i) * LDF + c);
#pragma unroll
                    for (int i = 0; i < 8; ++i) { const float inv = 127.0f / fmaxf(__uint_as_float(rowmax[i0 + i]) * 1.004f, 1e-30f); f32x4 a, b; unpk8(w8[i], a, b); unsigned q_[8];
#pragma unroll
                        for (int e_ = 0; e_ < 4; ++e_) { q_[e_] = __float_as_uint(fmaf(a[e_], inv, 12582912.0f)); q_[4 + e_] = __float_as_uint(fmaf(b[e_], inv, 12582912.0f)); }
                        v2u o_; o_.x = __builtin_amdgcn_perm(q_[1], q_[0], 0x0c0c0400u) | __builtin_amdgcn_perm(q_[3], q_[2], 0x04000c0cu); o_.y = __builtin_amdgcn_perm(q_[5], q_[4], 0x0c0c0400u) | __builtin_amdgcn_perm(q_[7], q_[6], 0x04000c0cu);
                        *(v2u*)(ws + WS_A8 + (size_t)(r0 + i0 + i) * LDA8 + c) = o_; } }
            }
        }
        for (int it = blockIdx.x * 512 + tid; it < MS * NOCT; it += F.G * 512) {
            const int b = it / NOCT, oct = it - b * NOCT, c = oct * 8, row = MP + b;
            f32x4 wg[3][2], wv[3][2];
#pragma unroll
            for (int j = 0; j < 3; ++j) { wg[j][0] = *(const f32x4*)(w_ffn_conv + (size_t)j * NUP + c); wg[j][1] = *(const f32x4*)(w_ffn_conv + (size_t)j * NUP + c + 4);
                wv[j][0] = *(const f32x4*)(w_ffn_conv + (size_t)j * NUP + DFF + c); wv[j][1] = *(const f32x4*)(w_ffn_conv + (size_t)j * NUP + DFF + c + 4); }
            const float* sf = state_ffn + (size_t)b * 2 * NUP + c;
            const f32x4 g2a = *(const f32x4*)(sf), g2b = *(const f32x4*)(sf + 4), v2a = *(const f32x4*)(sf + DFF), v2b = *(const f32x4*)(sf + DFF + 4);
            const f32x4 g1a = *(const f32x4*)(sf + NUP), g1b = *(const f32x4*)(sf + NUP + 4), v1a = *(const f32x4*)(sf + NUP + DFF), v1b = *(const f32x4*)(sf + NUP + DFF + 4);
            f32x4 ga = (f32x4){0.f, 0.f, 0.f, 0.f}, gb = ga, va = ga, vb = ga; const float rsr = RSTD[row];
#pragma unroll
            for (int sp = 0; sp < 4; ++sp) { const float* p = (const float*)(ws + WS_PS9) + ((size_t)sp * 144 + b) * NUP + c; ga += *(const f32x4*)p; gb += *(const f32x4*)(p + 4); va += *(const f32x4*)(p + DFF); vb += *(const f32x4*)(p + DFF + 4); }
            ga = ga * rsr; gb = gb * rsr; va = va * rsr; vb = vb * rsr;
            const f32x4 cga = wg[0][0] * g2a + wg[1][0] * g1a + wg[2][0] * ga, cgb = wg[0][1] * g2b + wg[1][1] * g1b + wg[2][1] * gb;
            const f32x4 cva = wv[0][0] * v2a + wv[1][0] * v1a + wv[2][0] * va, cvb = wv[0][1] * v2b + wv[1][1] * v1b + wv[2][1] * vb;
            f32x4 oa, ob;
#pragma unroll
            for (int q = 0; q < 4; ++q) { oa[q] = silu(cga[q]) * cva[q]; ob[q] = silu(cgb[q]) * cvb[q]; }
            *(v4u*)(UPA + (size_t)row * LDF + c) = pk8(oa, ob);
            float* o0 = out + O_FS + (size_t)b * 2 * NUP + c;
            *(f32x4*)(o0) = g1a; *(f32x4*)(o0 + 4) = g1b; *(f32x4*)(o0 + DFF) = v1a; *(f32x4*)(o0 + DFF + 4) = v1b;
            *(f32x4*)(o0 + NUP) = ga; *(f32x4*)(o0 + NUP + 4) = gb; *(f32x4*)(o0 + NUP + DFF) = va; *(f32x4*)(o0 + NUP + DFF + 4) = vb;
        }
        }
        if (BOTH(10)) GRID_BAR(10);
    }
    if (IN(11)) { REP(11) {
        const int c = (int)blockIdx.x, nsd = DM / 256;
        pg8::Gemm gd{UPA, WDN, MPAD, DM, DFF, LDF}, gp{PBF, WPP, MPAD, DM, PLE, LDP};
        { pg8::StaticOrder S; S.init(MP, DM, F.G, c); pg8::EpiRes<1> E{nullptr, nullptr, out + O_Y, XN, LD4, PART, 2, nullptr, (float*)(ws + WS_PARTM), (const float*)(ws + WS_RS2), (const float*)(ws + WS_SWD)};
          pg8::Gemm gd8{(const bf16*)(ws + WS_A8), (const bf16*)(ws + WS_WD8), MPAD, DM, DFF / 2, LDA8 / 2};
          pg8::gemm_phase<pg8::EpiRes<1>, pg8::StaticOrder, true, true, false, false, true>(F.lds + RING_OFF, gd8, S, E); }
        { pg8::Gemm gs{UPA, WDN, MPAD, DM, 640, LDF}; pg8::SplitOrder S2{MP / 256, nsd, 10, 0, 0, 640, 0, (nsd) * (10), c, 0}; pg8::EpiF32 E{(float*)(ws + WS_PS10), DM, 1, 128};
          pg8::gemm_phase<pg8::EpiF32, pg8::SplitOrder, true, true, true>(F.lds + RING_OFF, gs, S2, E); }
        { pg8::Gemm gs{UPA, WDN, MPAD, DM, 768, LDF}; pg8::SplitOrder S2{MP / 256, nsd, 6, 10, 6400, 768, 160, (nsd) * (6), c, 0}; pg8::EpiF32 E{(float*)(ws + WS_PS10), DM, 1, 128};
          pg8::gemm_phase<pg8::EpiF32, pg8::SplitOrder, true, true, true>(F.lds + RING_OFF, gs, S2, E); }
        { pg8::StaticOrder S; S.init(MP, DM, F.G, c); pg8::EpiBf E{PP, DM, nullptr, 2, nullptr};
          pg8::gemm_phase<pg8::EpiBf, pg8::StaticOrder, true, true>(F.lds + RING_OFF, gp, S, E); }
        { pg8::PanelOrder S{MP / 256, nsd, 0, F.G, c}; pg8::EpiBf E{PP, DM, nullptr, 1, nullptr};
          pg8::gemm_phase<pg8::EpiBf, pg8::PanelOrder, true, true, true>(F.lds + RING_OFF, gp, S, E); }
        }
        if (BOTH(11)) GRID_BAR(11);
    }
    if (IN(12)) { REP(12) {
        PHASE_IDS;
        float* RS3 = (float*)(ws + WS_RS2); const float* PARTM = (const float*)(ws + WS_PARTM);
        for (int row = gw; row < MPAD; row += NGW) {
            if (row < MP) { const float s = wave_sum(PART[(size_t)row * 64 + lane]); float am = PARTM[(size_t)row * 64 + lane];
#pragma unroll
                for (int o = 1; o < 64; o <<= 1) am = fmaxf(am, __shfl_xor(am, o));
                am = fmaxf(am, 1e-30f); const float rstd = 1.0f / sqrtf(s * (1.0f / DM) + EPS);
                if (lane == 0) { RSTD[row] = rstd; RS3[row] = rstd * am * (1.0f / 127.0f); }
                const float inv = 127.0f / am;
                QUANT_ROW(XN + (size_t)row * LD4, ws + WS_H8 + (size_t)row * LD8, inv); }
            else if (row >= MROWS) { if (lane == 0) RSTD[row] = 0.f; }
        }
        { LAS float* red = (LAS float*)(F.lds);
          for (int r = blockIdx.x; r < MS; r += F.G) { const int row = MP + r; const float* PS = (const float*)(ws + WS_PS10) + (size_t)r * DM; float ss = 0.f;
#pragma unroll
              for (int j2 = 0; j2 < 2; ++j2) { const int col = 512 * wave + 256 * j2 + 4 * lane; float* op = out + O_Y + (size_t)row * DM + col; f32x4 h = *(const f32x4*)op;
#pragma unroll
                  for (int sp = 0; sp < 16; ++sp) h += *(const f32x4*)(PS + (size_t)sp * 128 * DM + col);
                  ss += (h[0] * h[0] + h[1] * h[1]) + (h[2] * h[2] + h[3] * h[3]);
                  *(f32x4*)op = h;
                  v2u o; o.x = pk2(h[0], h[1]); o.y = pk2(h[2], h[3]); *(v2u*)(XN + (size_t)row * LD4 + col) = o; }
              ss = wave_sum(ss); if (lane == 0) red[wave] = ss; __syncthreads();
              if (tid == 0) { const float tot = ((red[0] + red[1]) + (red[2] + red[3])) + ((red[4] + red[5]) + (red[6] + red[7])); RSTD[row] = 1.0f / sqrtf(tot * (1.0f / DM) + EPS); }
              __syncthreads(); } }
        }
        if (BOTH(12)) GRID_BAR(12);
    }
    if (IN(13)) { REP(13) {
        pg8::Gemm g{(const bf16*)(ws + WS_H8), (const bf16*)(ws + WS_WPGI), MPAD, DM, DM / 2, LD8 / 2};
        { pg8::StaticOrder S; S.init(MP, DM, F.G, (int)blockIdx.x); pg8::EpiPle E{(bf16*)(ws + WS_H3B), PP, (const float*)(ws + WS_RS2), PART, 2, XN, LD4, (const float*)(ws + WS_SWP)};
          pg8::gemm_phase<pg8::EpiPle, pg8::StaticOrder, true, true, false, false, true>(F.lds + RING_OFF, g, S, E); }
        { pg8::Gemm gs{XN, WPG, MPAD, DM, 256, LD4}; pg8::SplitOrder S2{MP / 256, DM / 256, 16, 0, 0, 256, 0, (DM / 256) * (16), (int)blockIdx.x, 0}; pg8::EpiF32 E{(float*)(ws + WS_PS12), DM, 1, 128};
          pg8::gemm_phase<pg8::EpiF32, pg8::SplitOrder, true, true, true>(F.lds + RING_OFF, gs, S2, E); }
        }
        if (BOTH(13)) GRID_BAR(13);
    }
    if (IN(14)) {
        PHASE_IDS;
        const float* g_final = inptr(23);
        for (int row = gw; row < MP; row += NGW) {
            float* yr = out + O_Y + (size_t)row * DM + 4 * lane;
            const float s = wave_sum(PART[(size_t)row * 64 + lane]); const float rstd = 1.0f / sqrtf(s * (1.0f / DM) + EPS);
            const bf16* hr = (const bf16*)(ws + WS_H3B) + (size_t)row * DM + 4 * lane;
            v2u hw[16];
#pragma unroll
            for (int j = 0; j < 16; ++j) hw[j] = *(const v2u*)(hr + 256 * j);
#pragma unroll
            for (int j = 0; j < 16; ++j) { const f32x4 g = *(const f32x4*)(g_final + 4 * lane + 256 * j);
                *(f32x4*)(yr + 256 * j) = (f32x4){bflo(hw[j].x), bfhi(hw[j].x), bflo(hw[j].y), bfhi(hw[j].y)} * rstd * g; }
        }
        { LAS float* red = (LAS float*)(F.lds);
          for (int r = blockIdx.x; r < MS; r += F.G) { const int row = MP + r; const float* PS = (const float*)(ws + WS_PS12) + (size_t)r * DM; const float rs2 = RSTD[row];
              f32x4 h[2]; float ss = 0.f;
#pragma unroll
              for (int j2 = 0; j2 < 2; ++j2) { const int col = 512 * wave + 256 * j2 + 4 * lane; f32x4 a = (f32x4){0.f, 0.f, 0.f, 0.f};
#pragma unroll
                  for (int sp = 0; sp < 16; ++sp) a += *(const f32x4*)(PS + (size_t)sp * 128 * DM + col);
                  f32x4 p; { const v2u pw = *(const v2u*)(PP + (size_t)row * DM + col); p = (f32x4){bflo(pw.x), bfhi(pw.x), bflo(pw.y), bfhi(pw.y)}; }
                  f32x4 hv = *(const f32x4*)(out + O_Y + (size_t)row * DM + col);
#pragma unroll
                  for (int q = 0; q < 4; ++q) hv[q] += sigm(a[q] * rs2) * p[q];
                  h[j2] = hv; ss += (hv[0] * hv[0] + hv[1] * hv[1]) + (hv[2] * hv[2] + hv[3] * hv[3]); }
              ss = wave_sum(ss); if (lane == 0) red[wave] = ss; __syncthreads();
              const float tot = ((red[0] + red[1]) + (red[2] + red[3])) + ((red[4] + red[5]) + (red[6] + red[7])); const float rstd = 1.0f / sqrtf(tot * (1.0f / DM) + EPS);
#pragma unroll
              for (int j2 = 0; j2 < 2; ++j2) { const int col = 512 * wave + 256 * j2 + 4 * lane; const f32x4 g = *(const f32x4*)(g_final + col); *(f32x4*)(out + O_Y + (size_t)row * DM + col) = h[j2] * rstd * g; }
              __syncthreads(); } }
    }
#undef IN
#undef BOTH
}

extern "C" void kernel_launch(void* const* d_in, const int* in_sizes, int n_in, void* d_out, int out_size, void* d_ws, size_t ws_size, hipStream_t stream) {
    static int grid = 0;
    if (grid == 0) {
        if (n_in != 24 || (size_t)out_size != O_END || ws_size < WS_END) { fprintf(stderr, "kernel_launch: unexpected sizes n_in %d out %d ws %zu\n", n_in, out_size, ws_size); grid = -1; return; }
        int dev = 0, cus = 0, per_cu = 0;
        if (hipGetDevice(&dev) != hipSuccess || hipDeviceGetAttribute(&cus, hipDeviceAttributeMultiprocessorCount, dev) != hipSuccess) { grid = -1; return; }
        if (hipFuncSetAttribute((const void*)mega_fwd, hipFuncAttributeMaxDynamicSharedMemorySize, LDS_BYTES) != hipSuccess) { fprintf(stderr, "kernel_launch: hipFuncSetAttribute failed\n"); grid = -1; return; }
        if (hipOccupancyMaxActiveBlocksPerMultiprocessor(&per_cu, (const void*)mega_fwd, NWAVES * 64, LDS_BYTES) != hipSuccess || per_cu < 1) { fprintf(stderr, "kernel_launch: occupancy query says %d blocks per CU\n", per_cu); (void)hipGetLastError(); grid = -1; return; }
        grid = cus;
    }
    if (grid < 0) return;
    if (hipMemsetAsync((char*)d_ws + WS_CTL, 0, CTL_ZERO_BYTES, stream) != hipSuccess) return;
    Args a{};
    for (int i = 0; i < 24; ++i) a.in[i] = (const float*)d_in[i];
    a.out = (float*)d_out; a.ws = (unsigned char*)d_ws;
    if (N_LAUNCHES == 1) { a.ph_lo = 0; a.ph_hi = NPHASE; hipLaunchKernelGGL(mega_fwd, dim3(grid), dim3(NWAVES * 64), LDS_BYTES, stream, a); }
    else for (int li = 0; li < NPHASE; ++li) { a.ph_lo = li; a.ph_hi = li + 1; hipLaunchKernelGGL(mega_fwd, dim3(grid), dim3(NWAVES * 64), LDS_BYTES, stream, a); }
}
```

```cpp
#include <hip/hip_runtime.h>
#include <cstdio>
#include <cstdint>
namespace pg8 {
#define PG8_LAS __attribute__((address_space(3)))
typedef unsigned short bf16_t;
typedef short bf16x8 __attribute__((ext_vector_type(8)));
typedef float f32x4 __attribute__((ext_vector_type(4)));
typedef unsigned u32x4 __attribute__((ext_vector_type(4)));
constexpr int BM = 256, BK = 64, HALF = 128, HTB = HALF * BK * 2  , STAGE_BYTES = 8 * HTB, NXCD = 8, WGM = 2;

__host__ __device__ __forceinline__ int lds_byte(int r, int c) { const int st = (r >> 4) * 2 + (c >> 5), rr = r & 15, cc = c & 31, ob = rr * 64 + cc * 2; return st * 1024 + (ob ^ (((ob >> 9) & 1) << 5)); }
__host__ __device__ __forceinline__ void stage_rc(int b, int& R, int& C) { const int st = b / 1024, sb = b % 1024, swz = sb ^ (((sb >> 9) & 1) << 5); R = (st >> 1) * 16 + swz / 64; C = (st & 1) * 32 + (swz % 64) / 2; }
__host__ __device__ __forceinline__ int perm32(int rho) { const int n = rho >> 4, i = rho & 15; return 8 * (i >> 2) + 4 * n + (i & 3); }

struct Unit { int pm, pn, am, kb; };
struct Gemm { const bf16_t* A; const bf16_t* Bt; int M, N, K, ld; };

struct StaticOrder {
    int nM, nN, nwg, G, c;
    __host__ __device__ void init(int M, int N, int G_, int c_) { nM = M / BM; nN = N / BM; nwg = nM * nN; G = G_; c = c_; }
    __host__ __device__ bool next(int i, Unit& u) const {
        const long L = (long)i * G + c; if (L >= nwg) return false;
        int wgid = (int)L; { const int q = nwg / NXCD, r = nwg % NXCD, xcd = wgid % NXCD, off = wgid / NXCD; wgid = (xcd < r ? xcd * (q + 1) : r * (q + 1) + (xcd - r) * q) + off; }
        const int nig = WGM * nN, gid = wgid / nig, fm = gid * WGM, gsz = (nM - fm) < WGM ? (nM - fm) : WGM;
        u.pm = fm + ((wgid % nig) % gsz); u.pn = (wgid % nig) / gsz; u.am = u.pm; u.kb = 0; return true;
    }
    __device__ __forceinline__ void a_ready(const Unit&) const {}
    __device__ __forceinline__ void done(const Unit&) const {}
};

typedef __bf16 bf2_t __attribute__((ext_vector_type(2)));
typedef float f2_t __attribute__((ext_vector_type(2)));
__device__ __forceinline__ unsigned pk2(float lo, float hi) { f2_t v = {lo, hi}; bf2_t r = __builtin_convertvector(v, bf2_t); return __builtin_bit_cast(unsigned, r); }
__device__ __forceinline__ float bflo(unsigned w) { return __uint_as_float(w << 16); }
__device__ __forceinline__ float bfhi(unsigned w) { return __uint_as_float(w & 0xffff0000u); }
__device__ __forceinline__ u32x4 pk8(const f32x4& a, const f32x4& b) { u32x4 w; w.x = pk2(a[0], a[1]); w.y = pk2(a[2], a[3]); w.z = pk2(b[0], b[1]); w.w = pk2(b[2], b[3]); return w; }
__device__ __forceinline__ void unpk8(const u32x4& w, f32x4& a, f32x4& b) { a = (f32x4){bflo(w.x), bfhi(w.x), bflo(w.y), bfhi(w.y)}; b = (f32x4){bflo(w.z), bfhi(w.z), bflo(w.w), bfhi(w.w)}; }
__device__ __forceinline__ float sigm(float x) { return __builtin_amdgcn_rcpf(1.0f + __builtin_amdgcn_exp2f(-1.44269504089f * x)); }
__device__ __forceinline__ f32x4 sigm4(const f32x4& x) { return (f32x4){sigm(x[0]), sigm(x[1]), sigm(x[2]), sigm(x[3])}; }
typedef unsigned u32x2 __attribute__((ext_vector_type(2)));
typedef int i32x4_t __attribute__((ext_vector_type(4)));
typedef int i32x8_t __attribute__((ext_vector_type(8)));
__device__ __forceinline__ i32x8_t cat8(const bf16x8& lo, const bf16x8& hi) { const i32x4_t a = __builtin_bit_cast(i32x4_t, lo), b = __builtin_bit_cast(i32x4_t, hi); return __builtin_shufflevector(a, b, 0, 1, 2, 3, 4, 5, 6, 7); }
__device__ __forceinline__ unsigned pk4f8(float a, float b, float c, float d) { int w = 0; w = __builtin_amdgcn_cvt_pk_fp8_f32(a, b, w, false); w = __builtin_amdgcn_cvt_pk_fp8_f32(c, d, w, true); return (unsigned)w; }
constexpr int MROWS = 8320;

struct PanelOrder {
    int pm, n, c0, nc, c;
    __device__ __forceinline__ bool next(int i, Unit& u) const { const int L = i * nc + (c - c0); if (c < c0 || c >= c0 + nc || L >= n) return false; u.pm = pm; u.pn = L; u.am = pm; u.kb = 0; return true; }
    __device__ __forceinline__ void a_ready(const Unit&) const {}
    __device__ __forceinline__ void done(const Unit&) const {}
};
struct SplitOrder {
    int am, ntile, nsplit, s0, kbase, klen, c0, nc, c, deal;
    __device__ __forceinline__ bool next(int i, Unit& u) const {
        int L;
        if (deal == 0) { L = i * nc + (c - c0); if (c < c0 || c >= c0 + nc) return false; }
        else if (deal == 1) { if (c >= 192) { if (i >= 4) return false; L = (c - 192) + 64 * i; } else { if (i > 0) return false; L = 256 + c; } }
        else { if (c >= 192) { if (i >= 3) return false; L = (c - 192) + 64 * i; } else { if (i > 0) return false; L = 192 + c; } }
        if (L >= ntile * nsplit) return false;
        const int sl = L / ntile; u.pn = L - sl * ntile; u.pm = s0 + sl; u.am = am; u.kb = (kbase + sl * klen) * 2; return true; }
    __device__ __forceinline__ void a_ready(const Unit&) const {}
    __device__ __forceinline__ void done(const Unit&) const {}
};
struct SameOrder { int n; __device__ __forceinline__ bool next(int i, Unit& u) const { if (i >= n) return false; u.pm = 0; u.pn = 0; u.am = 0; u.kb = 0; return true; }
    __device__ __forceinline__ void a_ready(const Unit&) const {}
    __device__ __forceinline__ void done(const Unit&) const {} };
struct EpiBf {
    static constexpr bool PERM = true, AFTER_DRAIN = false;
    bf16_t* O; int ldc; const float* rs; int nai; const float* ssq4;
    __device__ __forceinline__ void operator()(const f32x4 (&acc)[2][2][4][2], const Unit& u, int wr, int wc, int fr, int fq) const {
        const int row0 = u.pm * BM + wr * 64 + fr, col0 = u.pn * BM + wc * 32 + 8 * fq;
#pragma unroll
        for (int ai = 0; ai < 2; ++ai)
#pragma unroll
            for (int m = 0; m < 4; ++m) { if (ai >= nai) continue; const int row = row0 + ai * HALF + m * 16; bf16_t* rowp = O + (size_t)row * ldc + col0; float s = rs ? rs[row] : 1.0f;
                if (ssq4) { const f32x4 q4 = *(const f32x4*)(ssq4 + 4 * (size_t)row); s = 1.0f / sqrtf(((q4[0] + q4[1]) + (q4[2] + q4[3])) * (1.0f / 4096.0f) + 1e-6f); }
#pragma unroll
                for (int bj = 0; bj < 2; ++bj) *(u32x4*)(rowp + bj * HALF) = pk8(acc[ai][bj][m][0] * s, acc[ai][bj][m][1] * s); }
    }
};
struct EpiF32 {
    static constexpr bool PERM = true, AFTER_DRAIN = false;
    float* C; int ldc; int nai; int rpm;
    __device__ __forceinline__ void operator()(const f32x4 (&acc)[2][2][4][2], const Unit& u, int wr, int wc, int fr, int fq) const {
        const int row0 = u.pm * rpm + wr * 64 + fr, col0 = u.pn * BM + wc * 32 + 8 * fq;
#pragma unroll
        for (int ai = 0; ai < 2; ++ai)
#pragma unroll
            for (int m = 0; m < 4; ++m) { if (ai >= nai) continue; float* rowp = C + (size_t)(row0 + ai * HALF + m * 16) * ldc + col0;
#pragma unroll
                for (int bj = 0; bj < 2; ++bj) { *(f32x4*)(rowp + bj * HALF) = acc[ai][bj][m][0]; *(f32x4*)(rowp + bj * HALF + 4) = acc[ai][bj][m][1]; } }
    }
};
struct EpiBfI8 {
    static constexpr bool PERM = true, AFTER_DRAIN = false;
    bf16_t* O; int ldc; const float* rs; const float* cs; int nai;
    __device__ __forceinline__ void operator()(const f32x4 (&acc)[2][2][4][2], const Unit& u, int wr, int wc, int fr, int fq) const {
        const int row0 = u.pm * BM + wr * 64 + fr, col0 = u.pn * BM + wc * 32 + 8 * fq;
        f32x4 c0[2], c1[2];
#pragma unroll
        for (int bj = 0; bj < 2; ++bj) { c0[bj] = *(const f32x4*)(cs + col0 + bj * HALF); c1[bj] = *(const f32x4*)(cs + col0 + bj * HALF + 4); }
        float sr[2][4];
#pragma unroll
        for (int ai = 0; ai < 2; ++ai)
#pragma unroll
            for (int m = 0; m < 4; ++m) sr[ai][m] = ai < nai ? rs[row0 + ai * HALF + m * 16] : 0.f;
#pragma unroll
        for (int ai = 0; ai < 2; ++ai)
#pragma unroll
            for (int m = 0; m < 4; ++m) { if (ai >= nai) continue; const int row = row0 + ai * HALF + m * 16; bf16_t* rowp = O + (size_t)row * ldc + col0; const float s = sr[ai][m];
#pragma unroll
                for (int bj = 0; bj < 2; ++bj) { const i32x4_t a0 = __builtin_bit_cast(i32x4_t, acc[ai][bj][m][0]), a1 = __builtin_bit_cast(i32x4_t, acc[ai][bj][m][1]);
                    const f32x4 sc0 = c0[bj] * s, sc1 = c1[bj] * s; const f32x4 f0 = (f32x4){(float)a0[0], (float)a0[1], (float)a0[2], (float)a0[3]} * sc0, f1 = (f32x4){(float)a1[0], (float)a1[1], (float)a1[2], (float)a1[3]} * sc1;
                    *(u32x4*)(rowp + bj * HALF) = pk8(f0, f1); } }
    }
};
struct EpiF32S {
    static constexpr bool PERM = true, AFTER_DRAIN = false;
    float* C; int ldc;
    __device__ __forceinline__ void operator()(const f32x4 (&acc)[2][2][4][2], const Unit& u, int wr, int wc, int fr, int fq) const {
        const int row0 = u.pm * 144 + wr * 64 + fr, col0 = u.pn * BM + wc * 32 + 8 * fq;
#pragma unroll
        for (int ai = 0; ai < 2; ++ai)
#pragma unroll
            for (int m = 0; m < 4; ++m) { if (ai == 1 && (m != 0 || wr != 0)) continue; float* rowp = C + (size_t)(row0 + ai * HALF + m * 16) * ldc + col0;
#pragma unroll
                for (int bj = 0; bj < 2; ++bj) { *(f32x4*)(rowp + bj * HALF) = acc[ai][bj][m][0]; *(f32x4*)(rowp + bj * HALF + 4) = acc[ai][bj][m][1]; } }
    }
};
struct EpiGate1 {
    static constexpr bool PERM = true, AFTER_DRAIN = false;
    const bf16_t* G; int ldg; bf16_t* O; int ldc; int nai;
    __device__ __forceinline__ void operator()(const f32x4 (&acc)[2][2][4][2], const Unit& u, int wr, int wc, int fr, int fq) const {
        const int row0 = u.pm * BM + wr * 64 + fr, col0 = u.pn * BM + wc * 32 + 8 * fq;
        u32x4 gw[2][4][2];
#pragma unroll
        for (int ai = 0; ai < 2; ++ai)
#pragma unroll
            for (int m = 0; m < 4; ++m) { if (ai >= nai) continue; const bf16_t* gp = G + (size_t)(row0 + ai * HALF + m * 16) * ldg + col0;
#pragma unroll
                for (int bj = 0; bj < 2; ++bj) gw[ai][m][bj] = *(const u32x4*)(gp + bj * HALF); }
#pragma unroll
        for (int ai = 0; ai < 2; ++ai)
#pragma unroll
            for (int m = 0; m < 4; ++m) { if (ai >= nai) continue; bf16_t* op = O + (size_t)(row0 + ai * HALF + m * 16) * ldc + col0;
#pragma unroll
                for (int bj = 0; bj < 2; ++bj) { f32x4 g0, g1; unpk8(gw[ai][m][bj], g0, g1);
                    *(u32x4*)(op + bj * HALF) = pk8(acc[ai][bj][m][0] * sigm4(g0), acc[ai][bj][m][1] * sigm4(g1)); } }
    }
};
struct EpiGate2 {
    static constexpr bool PERM = true, AFTER_DRAIN = false;
    const bf16_t* G; int ldg; bf16_t* O; int ldc; int nai; const float* rsq; const float* csq;
    __device__ __forceinline__ void operator()(const f32x4 (&acc)[2][2][4][2], const Unit& u, int wr, int wc, int fr, int fq) const {
        const int row0 = u.pm * BM + wr * 64 + fr, col0 = u.pn * BM + wc * 32 + 8 * fq;
#pragma unroll
        for (int ai = 0; ai < 2; ++ai) { if (ai >= nai) continue;
            u32x4 gw[4][2], tw[4][2];
#pragma unroll
            for (int m = 0; m < 4; ++m) { const int row = row0 + ai * HALF + m * 16; const bf16_t* gp = G + (size_t)row * ldg + col0; const bf16_t* op = O + (size_t)row * ldc + col0;
#pragma unroll
                for (int bj = 0; bj < 2; ++bj) { gw[m][bj] = *(const u32x4*)(gp + bj * HALF); tw[m][bj] = *(const u32x4*)(op + bj * HALF); } }
#pragma unroll
            for (int m = 0; m < 4; ++m) { bf16_t* op = O + (size_t)(row0 + ai * HALF + m * 16) * ldc + col0;
#pragma unroll
                for (int bj = 0; bj < 2; ++bj) { f32x4 g0, g1, t0, t1; unpk8(gw[m][bj], g0, g1); unpk8(tw[m][bj], t0, t1);
                    f32x4 a0 = acc[ai][bj][m][0], a1 = acc[ai][bj][m][1];
                    if (csq) { const i32x4_t i0 = __builtin_bit_cast(i32x4_t, a0), i1 = __builtin_bit_cast(i32x4_t, a1); const float sq = rsq[row0 + ai * HALF + m * 16];
                        a0 = (f32x4){(float)i0[0], (float)i0[1], (float)i0[2], (float)i0[3]} * (*(const f32x4*)(csq + col0 + bj * HALF) * sq); a1 = (f32x4){(float)i1[0], (float)i1[1], (float)i1[2], (float)i1[3]} * (*(const f32x4*)(csq + col0 + bj * HALF + 4) * sq); }
                    *(u32x4*)(op + bj * HALF) = pk8(t0 + a0 * sigm4(g0), t1 + a1 * sigm4(g1)); } }
            asm volatile("" ::: "memory"); }
    }
};
template <int SRC> struct EpiRes {
    static constexpr bool PERM = true, AFTER_DRAIN = false;
    const float* xp; const float* xs; float* out; bf16_t* XN; int ldx; float* part; int nai; unsigned char* h8; float* partm; const float* rsq; const float* csq;
    __device__ __forceinline__ void operator()(const f32x4 (&acc)[2][2][4][2], const Unit& u, int wr, int wc, int fr, int fq) const {
        const int row0 = u.pm * BM + wr * 64 + fr, col0 = u.pn * BM + wc * 32 + 8 * fq;
#pragma unroll
        for (int ai = 0; ai < 2; ++ai)
#pragma unroll
            for (int m = 0; m < 4; ++m) { if (ai >= nai) continue; const int row = row0 + ai * HALF + m * 16; const bool ok = row < MROWS;
                const float* hp = (row < 8192 ? xp + (size_t)row * 4096 : xs + (size_t)(row - 8192) * 4096) + col0;
                bf16_t* xn = XN + (size_t)row * ldx + col0; float ss = 0.f, am = 0.f;
#pragma unroll
                for (int bj = 0; bj < 2; ++bj) { f32x4 h0 = (f32x4){0.f, 0.f, 0.f, 0.f}, h1 = h0;
                    if (SRC == 0) { if (ok) { h0 = *(const f32x4*)(hp + bj * HALF); h1 = *(const f32x4*)(hp + bj * HALF + 4); } }
                    else { if (ok) { const u32x4 hw = *(const u32x4*)(xn + bj * HALF); unpk8(hw, h0, h1); } }
                    if (csq) { const i32x4_t i0 = __builtin_bit_cast(i32x4_t, acc[ai][bj][m][0]), i1 = __builtin_bit_cast(i32x4_t, acc[ai][bj][m][1]); const float sq = rsq[row];
                        const f32x4 c0 = *(const f32x4*)(csq + col0 + bj * HALF) * sq, c1 = *(const f32x4*)(csq + col0 + bj * HALF + 4) * sq;
                        h0 += (f32x4){(float)i0[0], (float)i0[1], (float)i0[2], (float)i0[3]} * c0; h1 += (f32x4){(float)i1[0], (float)i1[1], (float)i1[2], (float)i1[3]} * c1; }
                    else { h0 += acc[ai][bj][m][0]; h1 += acc[ai][bj][m][1]; }
                    ss += (h0[0] * h0[0] + h0[1] * h0[1]) + (h0[2] * h0[2] + h0[3] * h0[3]) + (h1[0] * h1[0] + h1[1] * h1[1]) + (h1[2] * h1[2] + h1[3] * h1[3]);
                    if (partm) am = fmaxf(am, fmaxf(fmaxf(fmaxf(fabsf(h0[0]), fabsf(h0[1])), fmaxf(fabsf(h0[2]), fabsf(h0[3]))), fmaxf(fmaxf(fabsf(h1[0]), fabsf(h1[1])), fmaxf(fabsf(h1[2]), fabsf(h1[3])))));
                    *(u32x4*)(xn + bj * HALF) = pk8(h0, h1);
                    }
                ss += __shfl_xor(ss, 16); ss += __shfl_xor(ss, 32);
                if (fq == 0) part[(size_t)row * 64 + u.pn * 4 + wc] = ss;
                if (partm) { am = fmaxf(am, __shfl_xor(am, 16)); am = fmaxf(am, __shfl_xor(am, 32)); if (fq == 0) partm[(size_t)row * 64 + u.pn * 4 + wc] = am; }
                if (SRC == 1 || (m & 1)) asm volatile("" ::: "memory"); }
    }
};
struct EpiPle {
    static constexpr bool PERM = true, AFTER_DRAIN = false;
    bf16_t* h3b; const bf16_t* pp; const float* rs; float* part; int nai; const bf16_t* XN; int ldx; const float* cs;
    __device__ __forceinline__ void operator()(const f32x4 (&acc)[2][2][4][2], const Unit& u, int wr, int wc, int fr, int fq) const {
        const int row0 = u.pm * BM + wr * 64 + fr, col0 = u.pn * BM + wc * 32 + 8 * fq;
        f32x4 c0[2], c1[2];
#pragma unroll
        for (int bj = 0; bj < 2; ++bj) { c0[bj] = (f32x4){1.f, 1.f, 1.f, 1.f}; c1[bj] = c0[bj]; if (cs) { c0[bj] = *(const f32x4*)(cs + col0 + bj * HALF); c1[bj] = *(const f32x4*)(cs + col0 + bj * HALF + 4); } }
#pragma unroll
        for (int ai = 0; ai < 2; ++ai)
#pragma unroll
            for (int m = 0; m < 4; ++m) { if (ai >= nai) continue; const int row = row0 + ai * HALF + m * 16; const bool ok = row < MROWS; const float s = rs[row];
                const bf16_t* pr = pp + (size_t)row * 4096 + col0; float ss = 0.f;
#pragma unroll
                for (int bj = 0; bj < 2; ++bj) { f32x4 h0 = (f32x4){0.f, 0.f, 0.f, 0.f}, h1 = h0;
                    if (ok) { const u32x4 hw = *(const u32x4*)(XN + (size_t)row * ldx + col0 + bj * HALF); unpk8(hw, h0, h1); }
                    f32x4 p0, p1; { const u32x4 pw = *(const u32x4*)(pr + bj * HALF); unpk8(pw, p0, p1); }
                    f32x4 a0 = acc[ai][bj][m][0], a1 = acc[ai][bj][m][1];
                    if (cs) { const i32x4_t i0 = __builtin_bit_cast(i32x4_t, a0), i1 = __builtin_bit_cast(i32x4_t, a1); a0 = (f32x4){(float)i0[0], (float)i0[1], (float)i0[2], (float)i0[3]} * c0[bj]; a1 = (f32x4){(float)i1[0], (float)i1[1], (float)i1[2], (float)i1[3]} * c1[bj]; }
                    h0 += sigm4(a0 * s) * p0; h1 += sigm4(a1 * s) * p1;
                    ss += (h0[0] * h0[0] + h0[1] * h0[1]) + (h0[2] * h0[2] + h0[3] * h0[3]) + (h1[0] * h1[0] + h1[1] * h1[1]) + (h1[2] * h1[2] + h1[3] * h1[3]);
                    if (ok) *(u32x4*)(h3b + (size_t)row * 4096 + col0 + bj * HALF) = pk8(h0, h1); }
                ss += __shfl_xor(ss, 16); ss += __shfl_xor(ss, 32);
                if (fq == 0) part[(size_t)row * 64 + u.pn * 4 + wc] = ss; }
    }
};
template <class Epi, class Sched, bool ALIGN_EPI = false, bool SP2 = false, bool HALF_M = false, bool F8 = false, bool I8 = false>
__device__ __forceinline__ void gemm_phase(PG8_LAS unsigned char* lds, const Gemm g, const Sched& S, const Epi& E) {
    int tid; asm volatile("v_mov_b32 %0, %1" : "=v"(tid) : "v"(threadIdx.x));
    const int wid = __builtin_amdgcn_readfirstlane(tid >> 6), lane = tid & 63, wr = wid >> 2, wc = wid & 3, fr = lane & 15, fq = lane >> 4;
    const int K = g.K, nt = K / BK, ld = g.ld;
    unsigned voffA[2], voffB[2];
#pragma unroll
    for (int i = 0; i < 2; ++i) { int R, C; stage_rc(tid * 16 + i * 8192, R, C); const int Rb = Epi::PERM ? ((R & ~31) + perm32(R & 31)) : R;
        voffA[i] = (unsigned)(R * ld + C) * 2u; voffB[i] = (unsigned)(Rb * ld + C) * 2u; }
    const size_t kstep = (size_t)(BK * 2);
    const size_t hstep = (size_t)HALF * ld * 2;
    const size_t tstep = 2 * hstep;
    const unsigned ldsw = (unsigned)wid * 1024u;
    const int aoff = lds_byte(wr * 64 + fr, fq * 8), boff = lds_byte(wc * 32 + fr, fq * 8);
#define PG8_SA(b, h) (((b) * 2 + (h)) * HTB)
#define PG8_SB(b, h) ((4 + (b) * 2 + (h)) * HTB)
#define PG8_STAGE(bufoff, gbase, voff) do { _Pragma("unroll") for (int _i = 0; _i < 2; ++_i) \
        __builtin_amdgcn_global_load_lds((const unsigned*)((const char*)(gbase) + (voff)[_i]), (PG8_LAS unsigned*)(lds + (bufoff) + ldsw + _i * 8192), 16, 0, 0); } while (0)
#define PG8_LD8(p) __builtin_shufflevector(*(const PG8_LAS i32x4_t*)(p), *(const PG8_LAS i32x4_t*)((p) + 1024), 0, 1, 2, 3, 4, 5, 6, 7)
#define PG8_LDA(dst, b, h) do { _Pragma("unroll") for (int m = 0; m < 4; ++m) { if constexpr (F8) dst##8[m] = PG8_LD8(lds + PG8_SA(b, h) + aoff + m * 2048); else { _Pragma("unroll") for (int k = 0; k < 2; ++k) dst[m][k] = *(const PG8_LAS bf16x8*)(lds + PG8_SA(b, h) + aoff + m * 2048 + k * 1024); } } } while (0)
#define PG8_LDB(dst, b, h) do { _Pragma("unroll") for (int n = 0; n < 2; ++n) { if constexpr (F8) dst##8[n] = PG8_LD8(lds + PG8_SB(b, h) + boff + n * 2048); else { _Pragma("unroll") for (int k = 0; k < 2; ++k) dst[n][k] = *(const PG8_LAS bf16x8*)(lds + PG8_SB(b, h) + boff + n * 2048 + k * 1024); } } } while (0)
#define PG8_MMA(ai, bj, At, Bt) do { __builtin_amdgcn_s_setprio(1); _Pragma("unroll") for (int m = 0; m < 4; ++m) _Pragma("unroll") for (int n = 0; n < 2; ++n) { \
        if constexpr (F8) asm volatile("v_mfma_scale_f32_16x16x128_f8f6f4 %0, %1, %2, %0, %3, %3 op_sel_hi:[0,0,0]" : "+v"(acc[ai][bj][m][n]) : "v"(Bt##8[n]), "v"(At##8[m]), "v"(scl8)); \
        else if constexpr (I8) { _Pragma("unroll") for (int k = 0; k < 2; ++k) acc[ai][bj][m][n] = __builtin_bit_cast(f32x4, __builtin_amdgcn_mfma_i32_16x16x64_i8(__builtin_bit_cast(i32x4_t, Bt[n][k]), __builtin_bit_cast(i32x4_t, At[m][k]), __builtin_bit_cast(i32x4_t, acc[ai][bj][m][n]), 0, 0, 0)); } \
        else { _Pragma("unroll") for (int k = 0; k < 2; ++k) acc[ai][bj][m][n] = __builtin_amdgcn_mfma_f32_16x16x32_bf16(Bt[n][k], At[m][k], acc[ai][bj][m][n], 0, 0, 0); } } __builtin_amdgcn_s_setprio(0); } while (0)
#define PG8_WAIT_V(n) asm volatile("s_waitcnt vmcnt(" #n ")" ::: "memory")
#define PG8_WAIT_L(n) asm volatile("s_waitcnt lgkmcnt(" #n ")" ::: "memory")
#define PG8_BAR __builtin_amdgcn_s_barrier()
#define PG8_SCHED __builtin_amdgcn_sched_barrier(0)
    Unit cur, nxt; int ui = 0;
    if (!S.next(0, cur)) return;
    f32x4 acc[2][2][4][2];
#pragma unroll
    for (int a = 0; a < 2; ++a)
#pragma unroll
        for (int b = 0; b < 2; ++b)
#pragma unroll
            for (int m = 0; m < 4; ++m)
#pragma unroll
                for (int n = 0; n < 2; ++n) acc[a][b][m][n] = (f32x4){0.f, 0.f, 0.f, 0.f};
    bf16x8 At[4][2], B0[2][2], B1[2][2]; i32x8_t At8[4], B08[2], B18[2]; const int scl8 = 0x7c7c7c7c;
    const char* cA = (const char*)g.A + (size_t)cur.am * tstep + cur.kb; const char* cB = (const char*)g.Bt + (size_t)cur.pn * tstep + cur.kb;
    S.a_ready(cur);
    if constexpr (SP2) {
        PG8_STAGE(PG8_SB(0, 0), cB, voffB); PG8_STAGE(PG8_SB(0, 1), cB + hstep, voffB); PG8_STAGE(PG8_SA(0, 0), cA, voffA); PG8_STAGE(PG8_SA(0, 1), cA + hstep, voffA);
        if (wr == 1) PG8_BAR;
        PG8_WAIT_V(2); PG8_BAR;
        PG8_STAGE(PG8_SB(1, 0), cB + kstep, voffB); PG8_STAGE(PG8_SA(1, 0), cA + kstep, voffA); PG8_STAGE(PG8_SB(1, 1), cB + hstep + kstep, voffB);
        PG8_WAIT_V(6); PG8_BAR;
    } else {
        PG8_STAGE(PG8_SB(0, 0), cB, voffB); PG8_STAGE(PG8_SA(0, 0), cA, voffA); PG8_STAGE(PG8_SB(0, 1), cB + hstep, voffB); PG8_STAGE(PG8_SA(0, 1), cA + hstep, voffA);
        if (wr == 1) PG8_BAR;
        PG8_WAIT_V(4); PG8_BAR;
        PG8_STAGE(PG8_SB(1, 0), cB + kstep, voffB); PG8_STAGE(PG8_SA(1, 0), cA + kstep, voffA); PG8_STAGE(PG8_SB(1, 1), cB + hstep + kstep, voffB);
        PG8_WAIT_V(6); PG8_BAR;
    }
    for (;;) {
        const bool has_next = S.next(ui + 1, nxt);
        const char* nA = has_next ? (const char*)g.A + (size_t)nxt.am * tstep + nxt.kb : cA; const char* nB = has_next ? (const char*)g.Bt + (size_t)nxt.pn * tstep + nxt.kb : cB;
        for (int t = 0; t < nt; t += 2) {
            const bool last = (t == nt - 2);
            const char* a1 = cA + (size_t)(t + 1) * kstep;
            const char* a2 = last ? nA : cA + (size_t)(t + 2) * kstep; const char* b2 = last ? nB : cB + (size_t)(t + 2) * kstep;
            const char* a3 = a2 + kstep; const char* b3 = b2 + kstep;
            if (last && has_next) S.a_ready(nxt);
            if constexpr (SP2) {
            PG8_LDB(B0, 0, 0); PG8_LDB(B1, 0, 1); PG8_SCHED; PG8_LDA(At, 0, 0); PG8_STAGE(PG8_SA(1, 1), a1 + hstep, voffA);
            PG8_WAIT_V(8); PG8_WAIT_L(0); PG8_BAR; PG8_MMA(0, 0, At, B0); PG8_MMA(0, 1, At, B1); PG8_BAR; PG8_SCHED;
            if constexpr (!HALF_M) PG8_LDA(At, 0, 1); PG8_STAGE(PG8_SB(0, 0), b2, voffB); PG8_STAGE(PG8_SB(0, 1), b2 + hstep, voffB); PG8_STAGE(PG8_SA(0, 0), a2, voffA);
            PG8_WAIT_V(8); PG8_WAIT_L(0); PG8_BAR; if constexpr (!HALF_M) PG8_MMA(1, 0, At, B0); if constexpr (!HALF_M) PG8_MMA(1, 1, At, B1); PG8_BAR; PG8_SCHED;
            PG8_LDB(B0, 1, 0); PG8_LDB(B1, 1, 1); PG8_SCHED; PG8_LDA(At, 1, 0); PG8_STAGE(PG8_SA(0, 1), a2 + hstep, voffA);
            PG8_WAIT_V(8); PG8_WAIT_L(0); PG8_BAR; PG8_MMA(0, 0, At, B0); PG8_MMA(0, 1, At, B1); PG8_BAR; PG8_SCHED;
            if constexpr (!HALF_M) PG8_LDA(At, 1, 1); PG8_STAGE(PG8_SB(1, 0), b3, voffB); PG8_STAGE(PG8_SB(1, 1), b3 + hstep, voffB); PG8_STAGE(PG8_SA(1, 0), a3, voffA);
            PG8_WAIT_V(8); PG8_WAIT_L(0); PG8_BAR; if constexpr (!HALF_M) PG8_MMA(1, 0, At, B0); if constexpr (!HALF_M) PG8_MMA(1, 1, At, B1); PG8_BAR; PG8_SCHED;
            } else {
            PG8_LDB(B0, 0, 0); PG8_SCHED; PG8_LDA(At, 0, 0); PG8_STAGE(PG8_SA(1, 1), a1 + hstep, voffA);
            PG8_WAIT_L(8); PG8_BAR; PG8_WAIT_L(0); PG8_MMA(0, 0, At, B0); PG8_BAR; PG8_SCHED;
            PG8_LDB(B1, 0, 1); PG8_STAGE(PG8_SB(0, 0), b2, voffB);
            PG8_BAR; PG8_WAIT_L(0); PG8_MMA(0, 1, At, B1); PG8_BAR;
            if constexpr (!HALF_M) PG8_LDA(At, 0, 1); PG8_STAGE(PG8_SA(0, 0), a2, voffA);
            PG8_BAR; PG8_WAIT_L(0); if constexpr (!HALF_M) PG8_MMA(1, 0, At, B0); PG8_BAR; PG8_SCHED;
            PG8_STAGE(PG8_SB(0, 1), b2 + hstep, voffB);
            PG8_WAIT_V(6); PG8_BAR; if constexpr (!HALF_M) PG8_MMA(1, 1, At, B1); PG8_BAR;
            PG8_LDB(B0, 1, 0); PG8_SCHED; PG8_LDA(At, 1, 0); PG8_STAGE(PG8_SA(0, 1), a2 + hstep, voffA);
            PG8_WAIT_L(8); PG8_BAR; PG8_WAIT_L(0); PG8_MMA(0, 0, At, B0); PG8_BAR; PG8_SCHED;
            PG8_LDB(B1, 1, 1); PG8_STAGE(PG8_SB(1, 0), b3, voffB);
            PG8_BAR; PG8_WAIT_L(0); PG8_MMA(0, 1, At, B1); PG8_BAR;
            if constexpr (!HALF_M) PG8_LDA(At, 1, 1); PG8_STAGE(PG8_SA(1, 0), a3, voffA);
            PG8_BAR; PG8_WAIT_L(0); if constexpr (!HALF_M) PG8_MMA(1, 0, At, B0); PG8_BAR; PG8_SCHED;
            PG8_STAGE(PG8_SB(1, 1), b3 + hstep, voffB);
            PG8_WAIT_V(6); PG8_BAR; if constexpr (!HALF_M) PG8_MMA(1, 1, At, B1); PG8_BAR;
            }
        }
        if constexpr (F8) { asm volatile("s_nop 15\n\ts_nop 15" ::: "memory"); }
        if constexpr (ALIGN_EPI) { if (wr == 0) PG8_BAR; }
        if constexpr (!Epi::AFTER_DRAIN) { E(acc, cur, wr, wc, fr, fq); S.done(cur); }
        if (!has_next) break;
#pragma unroll
        for (int a = 0; a < 2; ++a)
#pragma unroll
            for (int b = 0; b < 2; ++b)
#pragma unroll
                for (int m = 0; m < 4; ++m)
#pragma unroll
                    for (int n = 0; n < 2; ++n) acc[a][b][m][n] = (f32x4){0.f, 0.f, 0.f, 0.f};
        cur = nxt; cA = nA; cB = nB; ++ui;
        if constexpr (ALIGN_EPI) { if (wr == 1) PG8_BAR; }
    }
    PG8_WAIT_V(0);
    if constexpr (!ALIGN_EPI) { if (wr == 0) PG8_BAR; }
    PG8_BAR;
    if constexpr (Epi::AFTER_DRAIN) { E.fused(acc, cur, wr, wc, fr, fq, lds, wid, lane); S.done(cur); }
#undef PG8_SA
#undef PG8_SB
#undef PG8_STAGE
#undef PG8_LDA
#undef PG8_LDB
#undef PG8_MMA
#undef PG8_WAIT_V
#undef PG8_WAIT_L
#undef PG8_BAR
#undef PG8_SCHED
}
}

constexpr int NWAVES = 8;
#ifndef MK_N_LAUNCHES
#define MK_N_LAUNCHES 1
#endif
constexpr int NPHASE = 15;
constexpr int N_LAUNCHES = MK_N_LAUNCHES;

constexpr int DM = 4096, TSEQ = 2048, NBATCH = 4, MP = NBATCH * TSEQ  , MS = 128  , MROWS = MP + MS  , MPAD = 8448  ;
constexpr int DC = 2048, NH = 8, DKH = 256, DVH = 256, RANK = 16, DFF = 11008, NUP = 2 * DFF  , PLE = 256, CHUNK = 32, NCHUNK = TSEQ / CHUNK;
constexpr int DIN = 22544, NZ = 22528;
constexpr int ZH = 0, ZC = 2048, ZB = 4096, ZK = 6144, ZQ = 8192, ZV = 10240, ZR = 12288, ZGA = 14336, ZGB = 18432;
constexpr int ZI8 = 8192;
constexpr int ALR_SRC = 14336;
constexpr float EPS = 1e-6f;
constexpr int PADK = 64, LD4 = DM + PADK  , LD2 = DC + PADK  , LDF = DFF + PADK  , LDP = PLE + PADK  ;
static_assert(pg8::MROWS == MROWS, "rows");
constexpr size_t O_Y = 0, O_CP = (size_t)MROWS * DM, O_CS = O_CP + (size_t)NBATCH * 2 * DC, O_GP = O_CS + (size_t)MS * 2 * DC, O_GS = O_GP + (size_t)NBATCH * NH * DKH * DVH,
                 O_FP = O_GS + (size_t)MS * NH * DKH * DVH, O_FS = O_FP + (size_t)NBATCH * 2 * NUP, O_END = O_FS + (size_t)MS * 2 * NUP;
static_assert(O_END == 109637632, "output size");

constexpr size_t MiB = 1u << 20;
constexpr size_t WS_CTL = 0, CTL_ZERO_BYTES = 1 * MiB;
constexpr size_t WS_ALR = 12 * MiB;
constexpr size_t WS_SSQ4 = 1 * MiB;
constexpr size_t WS_RSTD = 2 * MiB;
constexpr size_t WS_PART = 3 * MiB;
constexpr size_t WS_PBF = 6 * MiB;
constexpr size_t WS_WIN = 16 * MiB;
constexpr size_t WS_PACK = WS_WIN, WS_T1 = WS_WIN, WS_UPA = WS_WIN;
constexpr size_t WS_WOA = 196 * MiB;
constexpr size_t WS_WOB = 213 * MiB;
constexpr size_t WS_WMIX = 230 * MiB;
constexpr size_t WS_WUP = 263 * MiB;
constexpr size_t WS_WDN = 438 * MiB;
constexpr size_t WS_WPG = 525 * MiB;
constexpr size_t WS_WPP = 558 * MiB;
constexpr size_t WS_XN = 561 * MiB;
constexpr size_t WS_Z = 629 * MiB;
constexpr size_t WS_UP = WS_Z, WS_PP = WS_Z;
constexpr size_t PS_BYTES = (size_t)16 * 128 * DM * 4;
constexpr size_t WS_O = WS_XN  ;
constexpr size_t WS_PS4 = WS_XN  , WS_PS6 = WS_T1  , WS_PS10 = WS_Z + 140 * MiB  , WS_PS12 = WS_PS10;
constexpr size_t WS_A2 = 992 * MiB;
constexpr size_t WS_B2 = 1027 * MiB;
constexpr size_t WS_MRG = 1062 * MiB;
constexpr size_t WS_WU8 = 1130 * MiB;
constexpr size_t WS_END = 1240 * MiB;
constexpr int LD8 = DM + 128;
constexpr size_t WS_WG8 = WS_WIN + (size_t)14336 * LD4 * 2  , WS_WPG8 = WS_WPG  ;
constexpr size_t WS_X8 = WS_A2  , WS_H8 = WS_B2  ;
static_assert((size_t)MPAD * LD8 <= (size_t)MPAD * LD2 * 2 && WS_WG8 + (size_t)8192 * LD8 <= WS_WOA, "e4m3 maps");
constexpr size_t WS_WMAX = WS_CTL + 512 * 1024  , WS_PARTM = WS_ALR  ;
constexpr size_t WS_WMAX1 = WS_CTL + 640 * 1024  , WS_AMX4 = WS_SSQ4 + 256 * 1024  , WS_W8 = WS_WU8  ;
constexpr int LDA8 = DFF + 128;
constexpr size_t WS_A8 = WS_WUP  , WS_WD8 = WS_WOA  ;
constexpr size_t WS_SWD = WS_RSTD + 256 * 1024  ;
static_assert(WS_A8 + (size_t)MPAD * LDA8 <= WS_WDN && WS_WD8 + (size_t)DM * LDA8 <= WS_WUP && WS_SWD + DM * 4 <= WS_PART, "down int8 maps");
constexpr size_t WS_WMAXP = WS_CTL + 768 * 1024  , WS_WPGI = 1220 * MiB  , WS_SWP = WS_RSTD + 288 * 1024  ;
static_assert(WS_WPGI + (size_t)DM * LD8 <= WS_END && WS_SWP + DM * 4 <= WS_PART, "ple int8 map");
constexpr int LDB8 = DC + 128;
constexpr size_t WS_B8 = WS_WU8  , WS_WOB8 = WS_WU8 + 60 * MiB  ;
constexpr size_t WS_SWB = WS_RSTD + 272 * 1024  ;
static_assert(WS_W8 + (size_t)14336 * LD8 <= WS_WOB8 && WS_WOB8 + (size_t)DM * LDB8 <= WS_END && (size_t)MPAD * LDB8 <= 60 * MiB && WS_SWB + DM * 4 <= WS_PART, "GLA out int8 maps");
constexpr size_t WS_RS2 = WS_RSTD + 64 * 1024  , WS_SW = WS_RSTD + 128 * 1024  , WS_H1Q = WS_B2  ;
static_assert(WS_SW + NUP * 4 <= WS_PART && WS_WU8 + (size_t)NUP * LD8 <= WS_END && (size_t)MPAD * 64 * 4 <= 4 * MiB, "int8 maps");
constexpr size_t WS_H3B = WS_MRG  ;
constexpr size_t WS_PS1 = WS_MRG  , WS_PS9 = WS_MRG  ;
static_assert((size_t)4 * 128 * NZ * 4 <= (size_t)MPAD * LD4 * 2 && (size_t)4 * 144 * NUP * 4 <= (size_t)MPAD * LD4 * 2, "PS1 / PS9 fit MRG");
static_assert(WS_WIN + (size_t)NZ * LD4 * 2 <= WS_WOA && WS_UPA + (size_t)MPAD * LDF * 2 <= WS_WOA && WS_T1 + (size_t)MPAD * DM * 4 <= WS_WOA, "ws map 1");
static_assert(WS_WOA + (size_t)DM * LD2 * 2 <= WS_WOB && WS_WOB + (size_t)DM * LD2 * 2 <= WS_WMIX && WS_WMIX + (size_t)DM * LD4 * 2 <= WS_WUP && WS_WPG + (size_t)DM * LD4 * 2 <= WS_WPP && WS_WPP + (size_t)DM * LDP * 2 <= WS_XN, "ws map 1b");
static_assert(WS_WUP + (size_t)NUP * LD4 * 2 <= WS_WDN && WS_WDN + (size_t)DM * LDF * 2 <= WS_WPG && WS_XN + (size_t)MPAD * LD4 * 2 <= WS_Z && WS_Z + (size_t)MPAD * NZ * 2 <= WS_A2, "ws map 2");
static_assert(WS_A2 + (size_t)MPAD * LD2 * 2 <= WS_B2 && WS_B2 + (size_t)MPAD * LD2 * 2 <= WS_MRG && WS_MRG + (size_t)MPAD * LD4 * 2 <= WS_END && WS_PBF + (size_t)MPAD * LDP * 2 <= WS_ALR && WS_ALR + (size_t)4 * MROWS * 16 * 4 <= WS_WIN, "ws map 3");
constexpr int QTF_OFF = 0, KTF_OFF = 16384, VF_OFF = 32768, PF_OFF = 49152, DEC_OFF = 51200, PACK_BYTES = 52224;
static_assert(WS_PACK + (size_t)NBATCH * NCHUNK * NH * PACK_BYTES <= WS_WOA, "packs fit");
constexpr int CW_TMO = 0, CW_BAR = 4096;

constexpr int RING_OFF = 0, RING_BYTES = 131072;
constexpr int LDSCTL_OFF = 155648, MISC_OFF = LDSCTL_OFF + 320;
constexpr int LDS_BYTES = 163840;
static_assert(MISC_OFF + 128 <= LDS_BYTES, "LDS map");

#define GAS __attribute__((address_space(1)))
#define LAS __attribute__((address_space(3)))
typedef unsigned short bf16;
typedef unsigned v4u __attribute__((ext_vector_type(4)));
typedef unsigned v2u __attribute__((ext_vector_type(2)));
typedef float f32x4 __attribute__((ext_vector_type(4)));
typedef float f32x16 __attribute__((ext_vector_type(16)));
typedef short bf16x8 __attribute__((ext_vector_type(8)));
typedef GAS unsigned gu32;
#define RLX_AGENT __ATOMIC_RELAXED, __HIP_MEMORY_SCOPE_AGENT
#define LDS_WAIT() asm volatile("s_waitcnt lgkmcnt(0)" ::: "memory")
#define VM_WAIT() asm volatile("s_waitcnt vmcnt(0)" ::: "memory")
using pg8::pk2; using pg8::bflo; using pg8::bfhi; using pg8::pk8; using pg8::unpk8; using pg8::sigm;
__device__ __forceinline__ float ex2(float x) { return __builtin_amdgcn_exp2f(x); }
__device__ __forceinline__ float expf_fast(float x) { return __builtin_amdgcn_exp2f(1.44269504089f * x); }
__device__ __forceinline__ float logsig(float x) { return fminf(x, 0.f) - 0.69314718056f * __builtin_amdgcn_logf(1.0f + expf_fast(-fabsf(x))); }
__device__ __forceinline__ float silu(float x) { return x * sigm(x); }
__device__ __forceinline__ float wave_sum(float v) {
#pragma unroll
    for (int o = 1; o < 64; o <<= 1) v += __shfl_xor(v, o);
    return v;
}
#define MFMA32(a, b, c) __builtin_amdgcn_mfma_f32_32x32x16_bf16((a), (b), (c), 0, 0, 0)
#define FWHT_LANE(ctrl_, m_) do { const float sg_ = (lane & (m_)) ? -1.0f : 1.0f; _Pragma("unroll") for (int q_ = 0; q_ < 4; ++q_) { \
        const float ta_ = __int_as_float(__builtin_amdgcn_mov_dpp(__float_as_int(a[q_]), (ctrl_), 0xf, 0xf, true)), tb_ = __int_as_float(__builtin_amdgcn_mov_dpp(__float_as_int(b[q_]), (ctrl_), 0xf, 0xf, true)); \
        a[q_] = fmaf(a[q_], sg_, ta_); b[q_] = fmaf(b[q_], sg_, tb_); } } while (0)
__device__ __forceinline__ void fwht32(f32x4& a, int lane) {
    a = (f32x4){a[0] + a[1], a[0] - a[1], a[2] + a[3], a[2] - a[3]};
    a = (f32x4){a[0] + a[2], a[1] + a[3], a[0] - a[2], a[1] - a[3]};
#define FWHT_LANE4(ctrl_, m_) do { const float sg_ = (lane & (m_)) ? -1.0f : 1.0f; _Pragma("unroll") for (int q_ = 0; q_ < 4; ++q_) { \
        const float ta_ = __int_as_float(__builtin_amdgcn_mov_dpp(__float_as_int(a[q_]), (ctrl_), 0xf, 0xf, true)); a[q_] = fmaf(a[q_], sg_, ta_); } } while (0)
    FWHT_LANE4(0xB1, 1); FWHT_LANE4(0x4E, 2); FWHT_LANE4(0x128, 8);
#undef FWHT_LANE4
}
__device__ __forceinline__ void fwht64(f32x4& a, f32x4& b, int lane) {
    { const f32x4 s = a + b, d = a - b; a = s; b = d; }
    { const f32x4 ta = (f32x4){a[0] + a[2], a[1] + a[3], a[0] - a[2], a[1] - a[3]}, tb = (f32x4){b[0] + b[2], b[1] + b[3], b[0] - b[2], b[1] - b[3]}; a = ta; b = tb; }
    { const f32x4 ta = (f32x4){a[0] + a[1], a[0] - a[1], a[2] + a[3], a[2] - a[3]}, tb = (f32x4){b[0] + b[1], b[0] - b[1], b[2] + b[3], b[2] - b[3]}; a = ta; b = tb; }
    FWHT_LANE(0xB1, 1); FWHT_LANE(0x4E, 2); FWHT_LANE(0x128, 8);
}

#define XB_TMO      128
#define XB_XCNT(j)  (256  + 64 * (j))
#define XB_XSUB(j)  (1280 + 64 * (j))
#define XB_XGEN(j)  (2304 + 64 * (j))
#define XB_TOP      3328
#define XB_TOPGEN   3392
#define XCD_BAR_WORDS 3456
#define XB_SPIN_CAP (1u << 18)

__device__ __forceinline__ unsigned xb_ld(unsigned* p)              { return __hip_atomic_load(p, __ATOMIC_RELAXED, __HIP_MEMORY_SCOPE_AGENT); }
__device__ __forceinline__ unsigned xb_add(unsigned* p, unsigned v) { return __hip_atomic_fetch_add(p, v, __ATOMIC_RELAXED, __HIP_MEMORY_SCOPE_AGENT); }
__device__ __forceinline__ unsigned xb_xcc_id() { return (unsigned)__builtin_amdgcn_s_getreg((3 << 11) | 20) & 0xFu; }
#define XB_SPIN(cond, bar) do { unsigned _sp = 0; while (cond) { __builtin_amdgcn_s_sleep(1); \
    if ((++_sp & 255u) == 0u) { if (xb_ld(&(bar)[XB_TMO])) break; if (_sp > XB_SPIN_CAP) { atomicAdd(&(bar)[XB_TMO], 1u); break; } } } } while (0)

struct XcdBarrier {
    unsigned* bar; unsigned x;
    volatile LAS unsigned* st;
};

__device__ __forceinline__ XcdBarrier xcd_barrier_post(unsigned* bar, volatile LAS unsigned* st) {
    XcdBarrier b; b.bar = bar; b.x = xb_xcc_id(); b.st = st;
    if (threadIdx.x == 0) (void)xb_add(&bar[XB_XCNT(b.x)], 1u);
    return b;
}
__device__ __forceinline__ void xcd_barrier_complete(unsigned* bar, unsigned x, unsigned& nloc, unsigned& nx) {
    const unsigned G = gridDim.x * gridDim.y * gridDim.z;
    unsigned sum, cnt, mine, sp = 0u;
    for (;;) {
        sum = 0u; cnt = 0u; mine = 0u;
#pragma unroll
        for (unsigned j = 0; j < 16; ++j) { const unsigned c = xb_ld(&bar[XB_XCNT(j)]); sum += c; cnt += (c > 0u) ? 1u : 0u; mine = (j == x) ? c : mine; }
        if (sum == G) break;
        __builtin_amdgcn_s_sleep(1);
        if ((++sp & 255u) == 0u) { if (xb_ld(&bar[XB_TMO])) break; if (sp > XB_SPIN_CAP) { atomicAdd(&bar[XB_TMO], 1u); break; } }
    }
    nloc = mine > 0u ? mine : 1u; nx = cnt > 0u ? cnt : 1u;
}

__device__ __forceinline__ void xcd_barrier(const XcdBarrier& b) {
    asm volatile("s_waitcnt vmcnt(0)" ::: "memory");
    __syncthreads();
    if (threadIdx.x == 0) {
        unsigned* bar = b.bar;
        __builtin_amdgcn_s_waitcnt(0);
        unsigned nloc = b.st[0], nx = b.st[1];
        if (nloc == 0u) { xcd_barrier_complete(bar, b.x, nloc, nx); b.st[0] = nloc; b.st[1] = nx; }
        const unsigned old = xb_add(&bar[XB_XSUB(b.x)], 1u);
        const unsigned gen = old / nloc;
        if (old + 1u == (gen + 1u) * nloc) {
            __builtin_amdgcn_fence(__ATOMIC_RELEASE, "agent");
            asm volatile("s_waitcnt vmcnt(0)" ::: "memory");
            const unsigned og = xb_add(&bar[XB_TOP], 1u);
            const unsigned tg = og / nx;
            if (og + 1u == (tg + 1u) * nx) xb_add(&bar[XB_TOPGEN], 1u);
            else XB_SPIN(xb_ld(&bar[XB_TOPGEN]) == tg, bar);
            __builtin_amdgcn_fence(__ATOMIC_ACQUIRE, "agent");
            xb_add(&bar[XB_XGEN(b.x)], 1u);
            asm volatile("s_waitcnt vmcnt(0)" ::: "memory");
        } else {
            XB_SPIN(xb_ld(&bar[XB_XGEN(b.x)]) == gen, bar);
            __builtin_amdgcn_fence(__ATOMIC_ACQUIRE, "agent");
            asm volatile("s_waitcnt vmcnt(0)" ::: "memory");
        }
    }
    __syncthreads();
}

__device__ __forceinline__ const float* inptr(int i) {
    const void* ka = (const void*)__builtin_amdgcn_kernarg_segment_ptr(); const float* p;
    asm volatile("s_load_dwordx2 %0, %1, %2\n\ts_waitcnt lgkmcnt(0)" : "=s"(p) : "s"(ka), "i"(i * 8) : "memory");
    return p;
}
struct Args {
    const float* in[24]; float* out; unsigned char* ws; int ph_lo, ph_hi;
};
struct Frame {
    LAS unsigned char* lds;
    int vcu, G;
};
__device__ __forceinline__ int fresh_tid() { int t; asm volatile("v_mov_b32 %0, %1" : "=v"(t) : "v"(threadIdx.x)); return t; }
#define PHASE_IDS const int tid = fresh_tid(), lane = tid & 63, wave = __builtin_amdgcn_readfirstlane(tid >> 6), gw = F.vcu * NWAVES + wave; (void)gw; (void)lane; (void)tid

struct TrB { const float* src; unsigned char* dst; const float* gain; unsigned* mx; int ldn, ldkb, nk64, f8; };
#define TRM(W, K_, N_, LDN_, SRC0_, GAIN_, DSTOFF_, LDKB_, F8_, MX_) { constexpr int nblk_ = (N_) / 64, nkb_ = ((K_) + 511) / 512, cnt_ = nkb_ * nblk_; if (r < cnt_) { const int kb = r / nblk_, nb = r - kb * nblk_, n0 = 64 * nb, k0 = 512 * kb; \
        T.src = (W) + (size_t)k0 * (LDN_) + (SRC0_) + n0; T.ldn = (LDN_); T.gain = (GAIN_) ? (GAIN_) + k0 : nullptr; T.dst = ws + (DSTOFF_) + (size_t)n0 * (LDKB_) + (size_t)k0 * ((F8_) ? 1 : 2); T.ldkb = (LDKB_); T.f8 = (F8_); T.mx = (MX_) ? (unsigned*)(ws + (MX_)) + n0 : nullptr; T.nk64 = ((K_) - k0) / 64; return true; } r -= cnt_; }
__device__ __forceinline__ bool tr_decode(int it, TrB& T, const float* w_in, const float* w_out_conv, const float* w_out_gla, const float* w_mix_out, const float* w_up, const float* w_down, const float* w_ple_gate, const float* w_ple_proj,
                                          const float* g_ffn, const float* g_ple, unsigned char* ws) {
    int r = it; const float* nog = nullptr;
    TRM(w_in, DM, 6144, DIN, 0, nog, WS_WIN, LD4 * 2, 0, 0)
    TRM(w_in, DM, 2048, DIN, 8192, nog, WS_WIN + (size_t)ZK * LD4 * 2, LD4 * 2, 0, 0)
    TRM(w_in, DM, 2048, DIN, 6144, nog, WS_WIN + (size_t)ZQ * LD4 * 2, LD4 * 2, 0, WS_WMAX1 + 4 * ZQ)
    TRM(w_in, DM, 4096, DIN, 10240, nog, WS_WIN + (size_t)ZV * LD4 * 2, LD4 * 2, 0, WS_WMAX1 + 4 * ZV)
    TRM(w_in, DM, 8192, DIN, ALR_SRC + RANK, nog, WS_WIN + (size_t)ZGA * LD4 * 2, LD4 * 2, 0, WS_WMAX1 + 4 * ZGA)
    TRM(w_up, DM, NUP, NUP, 0, g_ffn, WS_WUP, LD4 * 2, 0, WS_WMAX)
    TRM(w_down, DFF, DM, DM, 0, nog, WS_WDN, LDF * 2, 0, 0)
    TRM(w_out_conv, DC, DM, DM, 0, nog, WS_WOA, LD2 * 2, 0, 0)
    TRM(w_out_gla, DC, DM, DM, 0, nog, WS_WOB, LD2 * 2, 0, 0)
    TRM(w_mix_out, DM, DM, DM, 0, nog, WS_WMIX, LD4 * 2, 0, 0)
    TRM(w_ple_gate, DM, DM, DM, 0, g_ple, WS_WPG, LD4 * 2, 0, WS_WMAXP)
    TRM(w_ple_proj, PLE, DM, DM, 0, nog, WS_WPP, LDP * 2, 0, 0)
    return false;
}

#define QUANT_ROW(srcp, dstp, inv) do { v4u w_[8]; _Pragma("unroll") for (int j_ = 0; j_ < 8; ++j_) w_[j_] = *(const v4u*)((srcp) + 512 * j_ + 8 * lane); \
            _Pragma("unroll") for (int j_ = 0; j_ < 8; ++j_) { f32x4 a_, b_; unpk8(w_[j_], a_, b_); unsigned q_[8]; \
                _Pragma("unroll") for (int e_ = 0; e_ < 4; ++e_) { q_[e_] = __float_as_uint(fmaf(a_[e_], (inv), 12582912.0f)); q_[4 + e_] = __float_as_uint(fmaf(b_[e_], (inv), 12582912.0f)); } \
                v2u o_; o_.x = __builtin_amdgcn_perm(q_[1], q_[0], 0x0c0c0400u) | __builtin_amdgcn_perm(q_[3], q_[2], 0x04000c0cu); o_.y = __builtin_amdgcn_perm(q_[5], q_[4], 0x0c0c0400u) | __builtin_amdgcn_perm(q_[7], q_[6], 0x04000c0cu); \
                *(v2u*)((dstp) + 512 * j_ + 8 * lane) = o_; } } while (0)

__global__ void __launch_bounds__(NWAVES * 64, 2) mega_fwd(Args args) {
    extern __shared__ __attribute__((aligned(16))) unsigned char lds[];
    Frame F;
    F.lds = (LAS unsigned char*)lds;
    volatile LAS unsigned* MISC = (volatile LAS unsigned*)(F.lds + MISC_OFF);
    F.G = gridDim.x; { const int bx = blockIdx.x; F.vcu = (F.G % 8 == 0) ? (bx % 8) * (F.G / 8) + bx / 8 : bx; }
    unsigned char* ws = args.ws;
    gu32* ctl = (gu32*)(ws + WS_CTL);
    const int NGW = F.G * NWAVES;

    float* out = args.out;
    float* ALR = (float*)(ws + WS_ALR); float* SSQ4 = (float*)(ws + WS_SSQ4); float* RSTD = (float*)(ws + WS_RSTD); float* PART = (float*)(ws + WS_PART); bf16* PBF = (bf16*)(ws + WS_PBF);
    bf16* WIN = (bf16*)(ws + WS_WIN); bf16* WOA = (bf16*)(ws + WS_WOA); bf16* WOB = (bf16*)(ws + WS_WOB); bf16* WMIX = (bf16*)(ws + WS_WMIX);
    bf16* WUP = (bf16*)(ws + WS_WUP); bf16* WDN = (bf16*)(ws + WS_WDN); bf16* WPG = (bf16*)(ws + WS_WPG); bf16* WPP = (bf16*)(ws + WS_WPP);
    bf16* XN = (bf16*)(ws + WS_XN); bf16* Z = (bf16*)(ws + WS_Z); bf16* UP = (bf16*)(ws + WS_UP); bf16* PP = (bf16*)(ws + WS_PP);
    bf16* A2 = (bf16*)(ws + WS_A2); bf16* B2 = (bf16*)(ws + WS_B2); bf16* MRG = (bf16*)(ws + WS_MRG); float* T1 = (float*)(ws + WS_T1); bf16* UPA = (bf16*)(ws + WS_UPA);
    unsigned char* PACK = ws + WS_PACK;

    for (int u = threadIdx.x; u < (LDS_BYTES - LDSCTL_OFF) / 4; u += NWAVES * 64) ((LAS unsigned*)(F.lds + LDSCTL_OFF))[u] = 0u;
    __syncthreads();
    XcdBarrier bar; bar.bar = (unsigned*)(ctl + CW_BAR); bar.x = 0; bar.st = nullptr;
    if (N_LAUNCHES == 1) bar = xcd_barrier_post((unsigned*)(ctl + CW_BAR), MISC + 8);
#define GRID_BAR(seam) do { if (N_LAUNCHES != 1) { if (threadIdx.x == 0) __hip_atomic_store(ctl + CW_TMO, 0xBADBA0u | (unsigned)(seam), RLX_AGENT); } else { xcd_barrier(bar); } } while (0)
    const int lo = args.ph_lo, hi = args.ph_hi;
#ifdef ONLY_PHASE
#define IN(k) ((k) == ONLY_PHASE && lo <= (k) && (k) < hi)
#else
#define IN(k) (lo <= (k) && (k) < hi)
#endif
#define BOTH(k) (IN(k) && IN((k) + 1))
#ifndef DUP_MASK
#define DUP_MASK 0
#endif
#define REP(k) for (int rep_ = 0; rep_ < 1 + ((DUP_MASK >> (k)) & 1); ++rep_)

    if (IN(0)) { REP(0) {
        PHASE_IDS;
        const float* x_prompt = inptr(0); const float* x_sample = inptr(1); const float* p_prompt = inptr(2); const float* p_sample = inptr(3); const float* g_mix = inptr(7); const float* w_in = inptr(8); const float* w_out_conv = inptr(12); const float* w_out_gla = inptr(14); const float* w_mix_out = inptr(15); const float* g_ffn = inptr(16); const float* w_up = inptr(17); const float* w_down = inptr(19); const float* g_ple = inptr(20); const float* w_ple_gate = inptr(21); const float* w_ple_proj = inptr(22);
        for (int j = wave * F.G + F.vcu; j < (MROWS / 16) * 4; j += NWAVES * F.G) {
            const int ks = j & 3, row0 = 16 * (j >> 2), rl = lane & 15, kq = lane >> 4, row = row0 + rl, kb = 1024 * ks;
            const float* xr = (row < MP ? x_prompt + (size_t)row * DM : x_sample + (size_t)(row - MP) * DM) + kb + 8 * kq;
            float ss = 0.f;
            f32x4 acc = (f32x4){0.f, 0.f, 0.f, 0.f};
            const float* wb = w_in + (size_t)(kb + 8 * kq) * DIN + ALR_SRC + rl;
            bf16* xo = XN + (size_t)row * LD4 + kb + 8 * kq; float amx = 0.f;
#pragma unroll 4
            for (int sI = 0; sI < 1024 / 32; ++sI) {
                const f32x4 xa = *(const f32x4*)(xr + 32 * sI), xb = *(const f32x4*)(xr + 32 * sI + 4);
                const f32x4 ga = *(const f32x4*)(g_mix + kb + 32 * sI + 8 * kq), gb = *(const f32x4*)(g_mix + kb + 32 * sI + 8 * kq + 4);
                float w8[8];
#pragma unroll
                for (int jj = 0; jj < 8; ++jj) w8[jj] = wb[(size_t)(32 * sI + jj) * DIN];
                ss += ((xa[0] * xa[0] + xa[1] * xa[1]) + (xa[2] * xa[2] + xa[3] * xa[3])) + ((xb[0] * xb[0] + xb[1] * xb[1]) + (xb[2] * xb[2] + xb[3] * xb[3]));
                const f32x4 ya = xa * ga, yb = xb * gb; const v4u av = pk8(ya, yb);
                *(v4u*)(xo + 32 * sI) = av;
                amx = fmaxf(amx, fmaxf(fmaxf(fmaxf(fabsf(ya[0]), fabsf(ya[1])), fmaxf(fabsf(ya[2]), fabsf(ya[3]))), fmaxf(fmaxf(fabsf(yb[0]), fabsf(yb[1])), fmaxf(fabsf(yb[2]), fabsf(yb[3])))));
                v4u bh, bl;
                bh.x = pk2(w8[0], w8[1]); bh.y = pk2(w8[2], w8[3]); bh.z = pk2(w8[4], w8[5]); bh.w = pk2(w8[6], w8[7]);
                bl.x = pk2(w8[0] - bflo(bh.x), w8[1] - bfhi(bh.x)); bl.y = pk2(w8[2] - bflo(bh.y), w8[3] - bfhi(bh.y)); bl.z = pk2(w8[4] - bflo(bh.z), w8[5] - bfhi(bh.z)); bl.w = pk2(w8[6] - bflo(bh.w), w8[7] - bfhi(bh.w));
                acc = __builtin_amdgcn_mfma_f32_16x16x32_bf16(__builtin_bit_cast(bf16x8, av), __builtin_bit_cast(bf16x8, bh), acc, 0, 0, 0);
                acc = __builtin_amdgcn_mfma_f32_16x16x32_bf16(__builtin_bit_cast(bf16x8, av), __builtin_bit_cast(bf16x8, bl), acc, 0, 0, 0);
            }
            ss += __shfl_xor(ss, 16); ss += __shfl_xor(ss, 32);
            amx = fmaxf(amx, __shfl_xor(amx, 16)); amx = fmaxf(amx, __shfl_xor(amx, 32));
            if (kq == 0) { SSQ4[(size_t)row * 4 + ks] = ss; ((float*)(ws + WS_AMX4))[(size_t)row * 4 + ks] = amx; }
#pragma unroll
            for (int e = 0; e < 4; ++e) ALR[((size_t)ks * MROWS + row0 + 4 * kq + e) * 16 + rl] = acc[e];
        }
        {
            LAS float* scr = (LAS float*)(F.lds + RING_OFF + wave * 16640);
            TrB cur, nxt; f32x4 lc[16], ln[16];
            int it = F.vcu; bool has = tr_decode(it, cur, w_in, w_out_conv, w_out_gla, w_mix_out, w_up, w_down, w_ple_gate, w_ple_proj, g_ffn, g_ple, ws);
            if (has && wave < cur.nk64) {
#pragma unroll
                for (int i = 0; i < 16; ++i) lc[i] = *(const f32x4*)(cur.src + (size_t)(64 * wave + 4 * i + (lane >> 4)) * cur.ldn + 4 * (lane & 15));
            }
            while (has) {
                const int itn = it + F.G; const bool hasn = tr_decode(itn, nxt, w_in, w_out_conv, w_out_gla, w_mix_out, w_up, w_down, w_ple_gate, w_ple_proj, g_ffn, g_ple, ws);
                if (hasn && wave < nxt.nk64) {
#pragma unroll
                    for (int i = 0; i < 16; ++i) ln[i] = *(const f32x4*)(nxt.src + (size_t)(64 * wave + 4 * i + (lane >> 4)) * nxt.ldn + 4 * (lane & 15));
                }
                if (wave < cur.nk64) {
#pragma unroll
                    for (int i = 0; i < 16; ++i) { LAS float* d = scr + (4 * i + (lane >> 4)) * 65 + 4 * (lane & 15); d[0] = lc[i][0]; d[1] = lc[i][1]; d[2] = lc[i][2]; d[3] = lc[i][3]; }
                    LDS_WAIT(); asm volatile("" ::: "memory");
                    { const int c = lane & 7; f32x4 g0 = (f32x4){1.f, 1.f, 1.f, 1.f}, g1 = g0;
                      if (cur.gain) { g0 = *(const f32x4*)(cur.gain + 64 * wave + 8 * c); g1 = *(const f32x4*)(cur.gain + 64 * wave + 8 * c + 4); }
#pragma unroll
                      for (int jq = 0; jq < 8; ++jq) { const int n = (lane >> 3) + 8 * jq; const LAS float* sp = scr + (8 * c) * 65 + n;
                          const float e0 = sp[0 * 65] * g0[0], e1 = sp[1 * 65] * g0[1], e2 = sp[2 * 65] * g0[2], e3 = sp[3 * 65] * g0[3], e4 = sp[4 * 65] * g1[0], e5 = sp[5 * 65] * g1[1], e6 = sp[6 * 65] * g1[2], e7 = sp[7 * 65] * g1[3];
                          if (cur.mx) { float am = fmaxf(fmaxf(fmaxf(fabsf(e0), fabsf(e1)), fmaxf(fabsf(e2), fabsf(e3))), fmaxf(fmaxf(fabsf(e4), fabsf(e5)), fmaxf(fabsf(e6), fabsf(e7))));
                              am = fmaxf(am, __shfl_xor(am, 1)); am = fmaxf(am, __shfl_xor(am, 2)); am = fmaxf(am, __shfl_xor(am, 4));
                              if (c == 0) __hip_atomic_fetch_max(cur.mx + n, __float_as_uint(am), RLX_AGENT); }
                          if (cur.f8) { v2u o; o.x = pg8::pk4f8(e0 * 64.f, e1 * 64.f, e2 * 64.f, e3 * 64.f); o.y = pg8::pk4f8(e4 * 64.f, e5 * 64.f, e6 * 64.f, e7 * 64.f); *(v2u*)(cur.dst + (size_t)n * cur.ldkb + 64 * wave + 8 * c) = o; }
                          else { v4u o; o.x = pk2(e0, e1); o.y = pk2(e2, e3); o.z = pk2(e4, e5); o.w = pk2(e6, e7); *(v4u*)(cur.dst + (size_t)n * cur.ldkb + 2 * (64 * wave + 8 * c)) = o; } } }
                    LDS_WAIT(); asm volatile("" ::: "memory");
                }
                cur = nxt; it = itn; has = hasn;
#pragma unroll
                for (int i = 0; i < 16; ++i) lc[i] = ln[i];
            }
        }
        for (int row = gw; row < MPAD; row += NGW) {
            f32x4 pv = (f32x4){0.f, 0.f, 0.f, 0.f};
            if (row < MROWS) { const float* pr = row < MP ? p_prompt + (size_t)row * PLE : p_sample + (size_t)(row - MP) * PLE; pv = *(const f32x4*)(pr + 4 * lane); }
            v2u o; o.x = pk2(pv[0], pv[1]); o.y = pk2(pv[2], pv[3]);
            *(v2u*)(PBF + (size_t)row * LDP + 4 * lane) = o;
        }
        }
        if (BOTH(0)) GRID_BAR(0);
    }

    if (IN(1)) { REP(1) {
        { PHASE_IDS; float* RS1 = (float*)(ws + WS_RS2); float* SW1 = (float*)(ws + WS_SW);
          for (int row = gw; row < MP; row += NGW) { const f32x4 a4 = *(const f32x4*)((const float*)(ws + WS_AMX4) + 4 * (size_t)row), q4 = *(const f32x4*)(SSQ4 + 4 * (size_t)row);
              const float am = fmaxf(fmaxf(fmaxf(a4[0], a4[1]), fmaxf(a4[2], a4[3])), 1e-30f), rstd = 1.0f / sqrtf(((q4[0] + q4[1]) + (q4[2] + q4[3])) * (1.0f / 4096.0f) + 1e-6f);
              if (lane == 0) RS1[row] = rstd * am * (1.0f / 127.0f);
              const float inv = 127.0f / am;
              QUANT_ROW(XN + (size_t)row * LD4, ws + WS_X8 + (size_t)row * LD8, inv); }
          for (int n = ZI8 + gw; n < NZ; n += NGW) { const float am = fmaxf(__uint_as_float(((const unsigned*)(ws + WS_WMAX1))[n]), 1e-30f);
              if (lane == 0) SW1[n] = am * (1.0f / 127.0f);
              const float inv = 127.0f / am;
              QUANT_ROW(WIN + (size_t)n * LD4, ws + WS_W8 + (size_t)(n - ZI8) * LD8, inv); }
        }
        GRID_BAR(15);
        pg8::Gemm g{XN, WIN, MPAD, ZI8, DM, LD4}; pg8::Gemm g8{(const bf16*)(ws + WS_X8), (const bf16*)(ws + WS_W8), MPAD, NZ - ZI8, DM / 2, LD8 / 2};
        { pg8::StaticOrder S; S.init(MP, ZI8, F.G, (int)blockIdx.x); pg8::EpiBf E{Z, NZ, nullptr, 2, SSQ4};
          pg8::gemm_phase<pg8::EpiBf, pg8::StaticOrder, true, true>(F.lds + RING_OFF, g, S, E); }
        { pg8::StaticOrder S; S.init(MP, NZ - ZI8, F.G, (int)blockIdx.x); pg8::EpiBfI8 E{Z + ZI8, NZ, (const float*)(ws + WS_RS2), (const float*)(ws + WS_SW) + ZI8, 2};
          pg8::gemm_phase<pg8::EpiBfI8, pg8::StaticOrder, true, true, false, false, true>(F.lds + RING_OFF, g8, S, E); }
        { pg8::Gemm gs{XN, WIN, MPAD, NZ, 1024, LD4}; pg8::SplitOrder S2{MP / 256, NZ / 256, 4, 0, 0, 1024, 0, F.G, (int)blockIdx.x, 0}; pg8::EpiF32 E{(float*)(ws + WS_PS1), NZ, 1, 128};
          pg8::gemm_phase<pg8::EpiF32, pg8::SplitOrder, true, true, true>(F.lds + RING_OFF, gs, S2, E);
#ifdef PROBE_S1
          pg8::gemm_phase<pg8::EpiF32, pg8::SplitOrder, true, true, true>(F.lds + RING_OFF, gs, S2, E); pg8::gemm_phase<pg8::EpiF32, pg8::SplitOrder, true, true, true>(F.lds + RING_OFF, gs, S2, E);
#endif
        }
#if defined(PROBE_GEMM)
        {
            pg8::Gemm gq{XN, WIN, MPAD, DM, DM, LD4}; pg8::EpiBf Eq{MRG, LD4, nullptr, 2, nullptr};
#if PROBE_GEMM == 1
            pg8::StaticOrder Sq; Sq.init(MP, DM, F.G, (int)blockIdx.x); pg8::gemm_phase<pg8::EpiBf, pg8::StaticOrder, true, true>(F.lds + RING_OFF, gq, Sq, Eq);
#elif PROBE_GEMM == 2
            pg8::SameOrder Sq{2}; pg8::gemm_phase<pg8::EpiBf, pg8::SameOrder, true, true>(F.lds + RING_OFF, gq, Sq, Eq);
#else
            pg8::StaticOrder Sq; Sq.init(MP, DM, F.G, (int)blockIdx.x); pg8::gemm_phase<pg8::EpiBf, pg8::StaticOrder, true, true, true>(F.lds + RING_OFF, gq, Sq, Eq);
#endif
        }
#endif
        }
        if (BOTH(1)) GRID_BAR(1);
    }

    if (IN(2)) { REP(2) {
        PHASE_IDS;
        const float* w_conv = inptr(11); const float* state_conv = inptr(4); const float* w_alpha2 = inptr(9); const float* b_alpha = inptr(10);
        { const float* PS = (const float*)(ws + WS_PS1);
          for (int it = blockIdx.x * 512 + tid; it < MS * (NZ / 8); it += F.G * 512) { const int r = it / (NZ / 8), col = (it - r * (NZ / 8)) * 8, row = MP + r;
              const f32x4 q4 = *(const f32x4*)(SSQ4 + 4 * (size_t)row); const float rs0 = 1.0f / sqrtf(((q4[0] + q4[1]) + (q4[2] + q4[3])) * (1.0f / DM) + EPS);
              f32x4 a0 = (f32x4){0.f, 0.f, 0.f, 0.f}, a1 = a0;
#pragma unroll
              for (int sp = 0; sp < 4; ++sp) { const float* p = PS + ((size_t)sp * 128 + r) * NZ + col; a0 += *(const f32x4*)p; a1 += *(const f32x4*)(p + 4); }
              *(v4u*)(Z + (size_t)row * NZ + col) = pk8(a0 * rs0, a1 * rs0); } }
        for (int it = blockIdx.x * 512 + tid; it < (MP / 16) * (DC / 8); it += F.G * 512) {
            const int chunk = it >> 8, oct = it & 255, r0 = chunk * 16, t0 = r0 & (TSEQ - 1), c = oct * 8;
            f32x4 w0a = *(const f32x4*)(w_conv + c), w0b = *(const f32x4*)(w_conv + c + 4), w1a = *(const f32x4*)(w_conv + DC + c), w1b = *(const f32x4*)(w_conv + DC + c + 4),
                  w2a = *(const f32x4*)(w_conv + 2 * DC + c), w2b = *(const f32x4*)(w_conv + 2 * DC + c + 4);
            f32x4 um2a = (f32x4){0.f, 0.f, 0.f, 0.f}, um2b = um2a, um1a = um2a, um1b = um2a;
            if (t0 != 0) {
                const bf16* zr = Z + (size_t)(r0 - 2) * NZ + c; f32x4 ha, hb, ca, cb;
                unpk8(*(const v4u*)(zr + ZH), ha, hb); unpk8(*(const v4u*)(zr + ZC), ca, cb); um2a = ha * ca; um2b = hb * cb;
                unpk8(*(const v4u*)(zr + NZ + ZH), ha, hb); unpk8(*(const v4u*)(zr + NZ + ZC), ca, cb); um1a = ha * ca; um1b = hb * cb;
            }
#pragma unroll 1
            for (int i0 = 0; i0 < 16; i0 += 8) {
                v4u lh[8], lc_[8], lb[8];
#pragma unroll
                for (int i = 0; i < 8; ++i) { const bf16* zr = Z + (size_t)(r0 + i0 + i) * NZ + c; lh[i] = *(const v4u*)(zr + ZH); lc_[i] = *(const v4u*)(zr + ZC); lb[i] = *(const v4u*)(zr + ZB); }
#pragma unroll
                for (int i = 0; i < 8; ++i) { f32x4 ha, hb, ca, cb, ba, bb;
                    unpk8(lh[i], ha, hb); unpk8(lc_[i], ca, cb); unpk8(lb[i], ba, bb);
                    const f32x4 ua = ha * ca, ub = hb * cb;
                    const f32x4 oa = ba * (w0a * um2a + w1a * um1a + w2a * ua), ob = bb * (w0b * um2b + w1b * um1b + w2b * ub);
                    *(v4u*)(A2 + (size_t)(r0 + i0 + i) * LD2 + c) = pk8(oa, ob);
                    um2a = um1a; um2b = um1b; um1a = ua; um1b = ub; }
            }
            if (t0 + 16 == TSEQ) { const int b = r0 / TSEQ; float* o0 = out + O_CP + ((size_t)b * 2 + 0) * DC + c;
                *(f32x4*)(o0) = um2a; *(f32x4*)(o0 + 4) = um2b; *(f32x4*)(o0 + DC) = um1a; *(f32x4*)(o0 + DC + 4) = um1b; }
        }
        {
            LAS float* alr_s = (LAS float*)(F.lds + 0);
            LAS float* b_s = (LAS float*)(F.lds + 2048);
            LAS unsigned char* qt_s = F.lds + 34816;
            LAS unsigned char* kt_s = F.lds + 51712;
            LAS unsigned char* v_s = F.lds + 68608;
            for (int idx = blockIdx.x; idx < NBATCH * NCHUNK * NH; idx += F.G) {
                const int h = idx & 7, bc = idx >> 3, b = bc >> 6, c = bc & 63, row0 = b * TSEQ + c * CHUNK;
                unsigned char* pack = PACK + (size_t)idx * PACK_BYTES;
                v4u qv[2], kv[2], vv[2];
#pragma unroll
                for (int e = 0; e < 2; ++e) { const int ch = tid + 512 * e, t = ch >> 5, k8 = ch & 31; const bf16* zr = Z + (size_t)(row0 + t) * NZ + h * 256 + 8 * k8;
                    qv[e] = *(const v4u*)(zr + ZQ); kv[e] = *(const v4u*)(zr + ZK); vv[e] = *(const v4u*)(zr + ZV); }
                if (tid < 128) { const int rr = row0 + (tid >> 2); const f32x4 q4 = *(const f32x4*)(SSQ4 + 4 * (size_t)rr); const float rs0 = 1.0f / sqrtf(((q4[0] + q4[1]) + (q4[2] + q4[3])) * (1.0f / DM) + EPS);
                    const float* ap = ALR + (size_t)rr * 16 + 4 * (tid & 3);
                    *(LAS f32x4*)(alr_s + tid * 4) = ((*(const f32x4*)(ap) + *(const f32x4*)(ap + (size_t)MROWS * 16)) + (*(const f32x4*)(ap + (size_t)2 * MROWS * 16) + *(const f32x4*)(ap + (size_t)3 * MROWS * 16))) * rs0; }
                const int kk = 32 * wave + (lane & 31), th = lane >> 5;
                float w2r[16];
#pragma unroll
                for (int j = 0; j < 16; ++j) w2r[j] = w_alpha2[(size_t)j * (NH * DKH) + h * 256 + kk];
                const float bb = b_alpha[h * 256 + kk];
                __syncthreads();
                {
                    float bl[16]; float run = 0.f;
#pragma unroll
                    for (int i = 0; i < 16; ++i) { const int t = 16 * th + i; const LAS f32x4* ar = (const LAS f32x4*)(alr_s + t * 16);
                        const f32x4 a0 = ar[0], a1 = ar[1], a2 = ar[2], a3 = ar[3];
                        float x = bb;
                        x += a0[0] * w2r[0]; x += a0[1] * w2r[1]; x += a0[2] * w2r[2]; x += a0[3] * w2r[3];
                        x += a1[0] * w2r[4]; x += a1[1] * w2r[5]; x += a1[2] * w2r[6]; x += a1[3] * w2r[7];
                        x += a2[0] * w2r[8]; x += a2[1] * w2r[9]; x += a2[2] * w2r[10]; x += a2[3] * w2r[11];
                        x += a3[0] * w2r[12]; x += a3[1] * w2r[13]; x += a3[2] * w2r[14]; x += a3[3] * w2r[15];
                        run += logsig(x) * (1.0f / 16.0f); bl[i] = run; }
                    const float lo_tot = __shfl(run, lane & 31);
                    if (th) {
#pragma unroll
                        for (int i = 0; i < 16; ++i) bl[i] += lo_tot;
                    }
#pragma unroll
                    for (int i = 0; i < 16; ++i) b_s[(16 * th + i) * 256 + kk] = bl[i];
                }
                __syncthreads();
#pragma unroll
                for (int e = 0; e < 2; ++e) { const int ch = tid + 512 * e, t = ch >> 5, k8 = ch & 31;
                    const f32x4 b0 = *(const LAS f32x4*)(b_s + t * 256 + 8 * k8), b1 = *(const LAS f32x4*)(b_s + t * 256 + 8 * k8 + 4);
                    f32x4 e0, e1, i0, i1;
#pragma unroll
                    for (int q = 0; q < 4; ++q) { e0[q] = expf_fast(b0[q]); e1[q] = expf_fast(b1[q]); i0[q] = expf_fast(-b0[q]); i1[q] = expf_fast(-b1[q]); }
                    f32x4 q0, q1, k0, k1; unpk8(qv[e], q0, q1); unpk8(kv[e], k0, k1);
                    *(LAS v4u*)(qt_s + t * 528 + 16 * k8) = pk8(q0 * e0 * 0.0625f, q1 * e1 * 0.0625f);
                    *(LAS v4u*)(kt_s + t * 528 + 16 * k8) = pk8(k0 * i0, k1 * i1);
                    *(LAS v4u*)(v_s + t * 528 + 16 * k8) = vv[e];
                    if (t == 31) { *(f32x4*)(pack + DEC_OFF + 32 * k8) = e0; *(f32x4*)(pack + DEC_OFF + 32 * k8 + 16) = e1; } }
                __syncthreads();
                if (wave == 0) {
                    f32x16 acc;
#pragma unroll
                    for (int i = 0; i < 16; ++i) acc[i] = 0.f;
                    const int r = lane & 31, hh = lane >> 5;
#pragma unroll
                    for (int s = 0; s < 16; ++s) { const bf16x8 a = *(const LAS bf16x8*)(kt_s + r * 528 + (16 * s + 8 * hh) * 2), bq = *(const LAS bf16x8*)(qt_s + r * 528 + (16 * s + 8 * hh) * 2);
                        acc = MFMA32(a, bq, acc); }
#pragma unroll
                    for (int i = 0; i < 16; ++i) { const int srow = (i & 3) + 8 * (i >> 2) + 4 * hh; if (srow > r) acc[i] = 0.f; }
#pragma unroll
                    for (int st = 0; st < 2; ++st) { v4u w; w.x = pk2(acc[8 * st], acc[8 * st + 1]); w.y = pk2(acc[8 * st + 2], acc[8 * st + 3]); w.z = pk2(acc[8 * st + 4], acc[8 * st + 5]); w.w = pk2(acc[8 * st + 6], acc[8 * st + 7]);
                        *(v4u*)(pack + PF_OFF + (st * 64 + lane) * 16) = w; }
                }
#pragma unroll
                for (int e = 0; e < 2; ++e) { const int q = tid + 512 * e, ln = q & 63, r = ln & 31, hh = ln >> 5;
                    { const int sg = q >> 6;
                      const v2u lo2 = *(const LAS v2u*)(qt_s + r * 528 + (16 * sg + 4 * hh) * 2), hi2 = *(const LAS v2u*)(qt_s + r * 528 + (16 * sg + 8 + 4 * hh) * 2);
                      v4u w; w.x = lo2.x; w.y = lo2.y; w.z = hi2.x; w.w = hi2.y; *(v4u*)(pack + QTF_OFF + q * 16) = w; }
                    { const int i8 = q >> 7, st = (q >> 6) & 1; unsigned short kvv[8], vvv[8];
#pragma unroll
                      for (int j = 0; j < 8; ++j) { const int tt = 16 * st + 8 * (j >> 2) + 4 * hh + (j & 3);
                          kvv[j] = *(const LAS unsigned short*)(kt_s + tt * 528 + (32 * i8 + r) * 2); vvv[j] = *(const LAS unsigned short*)(v_s + tt * 528 + (32 * i8 + r) * 2); }
                      v4u wk, wv; wk.x = kvv[0] | ((unsigned)kvv[1] << 16); wk.y = kvv[2] | ((unsigned)kvv[3] << 16); wk.z = kvv[4] | ((unsigned)kvv[5] << 16); wk.w = kvv[6] | ((unsigned)kvv[7] << 16);
                      wv.x = vvv[0] | ((unsigned)vvv[1] << 16); wv.y = vvv[2] | ((unsigned)vvv[3] << 16); wv.z = vvv[4] | ((unsigned)vvv[5] << 16); wv.w = vvv[6] | ((unsigned)vvv[7] << 16);
                      *(v4u*)(pack + KTF_OFF + q * 16) = wk; *(v4u*)(pack + VF_OFF + q * 16) = wv; } }
                __syncthreads();
            }
        }
        }
        if (BOTH(2)) GRID_BAR(2);
    }

    if (IN(3)) { REP(3) {
        PHASE_IDS;
        const float* g_gla = inptr(13); const float* w_alpha2 = inptr(9); const float* b_alpha = inptr(10); const float* state_gla = inptr(5); const float* w_conv = inptr(11); const float* state_conv = inptr(4);
        if (blockIdx.x < 2 * NBATCH * NH) {
            const int bh = blockIdx.x >> 1, half = blockIdx.x & 1, b = bh >> 3, h = bh & 7, r = lane & 31, hh = lane >> 5;
            constexpr int CSLOT = 44032, C_VF = 32768, C_PF = 40960, C_DEC = 43008;
            const unsigned char* pk0 = PACK + (size_t)(b * NCHUNK * NH + h) * PACK_BYTES;
            float* Og = (float*)(ws + WS_O) + (size_t)(b * TSEQ) * (NH * DVH) + h * DVH + 128 * half;
            f32x16 S[8];
#ifdef DUP3A
            for (int rep3_ = 0; rep3_ < 2; ++rep3_) {
            VM_WAIT(); __syncthreads();
#else
            {
#endif
#pragma unroll
            for (int i = 0; i < 8; ++i)
#pragma unroll
                for (int e = 0; e < 16; ++e) S[i][e] = 0.f;
#define GLA_LOAD_PACK(cc, sl) do { const unsigned char* pn_ = pk0 + (size_t)(cc) * NH * PACK_BYTES; const int so_ = (sl) * CSLOT; \
        _Pragma("unroll") for (int k6_ = 0; k6_ < 6; ++k6_) { int p_ = wave + 8 * k6_; if (p_ >= 43) p_ = wave; const int pp_ = p_ < 32 ? p_ : (p_ < 40 ? 32 + 8 * half + (p_ - 32) : 48 + (p_ - 40)); \
            __builtin_amdgcn_global_load_lds((const unsigned*)(pn_ + pp_ * 1024 + lane * 16), (LAS unsigned*)(F.lds + so_ + p_ * 1024), 16, 0, 0); } } while (0)
            GLA_LOAD_PACK(0, 0); GLA_LOAD_PACK(1, 1);
            int sl = 0;
            for (int c = 0; c < NCHUNK; ++c) {
                if (c == NCHUNK - 1) asm volatile("s_waitcnt vmcnt(0)" ::: "memory");
                else if (wave >= 4 || c == 0) asm volatile("s_waitcnt vmcnt(6)" ::: "memory");
                else if (c == 1) asm volatile("s_waitcnt vmcnt(22)" ::: "memory");
                else asm volatile("s_waitcnt vmcnt(38)" ::: "memory");
                LDS_WAIT(); __builtin_amdgcn_s_barrier(); asm volatile("" ::: "memory");
                const int sl2 = sl == 0 ? 2 : sl - 1;
                if (c + 2 < NCHUNK) GLA_LOAD_PACK(c + 2, sl2);
                if (wave < 4) {
                    const LAS unsigned char* sb = F.lds + sl * CSLOT;
                    bf16x8 Vf[2], Pf[2];
#pragma unroll
                    for (int st = 0; st < 2; ++st) { Vf[st] = *(const LAS bf16x8*)(sb + C_VF + ((wave * 2 + st) * 64 + lane) * 16); Pf[st] = *(const LAS bf16x8*)(sb + C_PF + (st * 64 + lane) * 16); }
                    f32x16 o;
#pragma unroll
                    for (int e = 0; e < 16; ++e) o[e] = 0.f;
                    o = MFMA32(Pf[0], Vf[0], o); o = MFMA32(Pf[1], Vf[1], o);
#pragma unroll
                    for (int i = 0; i < 8; ++i)
#pragma unroll
                        for (int sI = 0; sI < 2; ++sI) { const bf16x8 a = *(const LAS bf16x8*)(sb + QTF_OFF + ((2 * i + sI) * 64 + lane) * 16);
                            v4u w; w.x = pk2(S[i][8 * sI], S[i][8 * sI + 1]); w.y = pk2(S[i][8 * sI + 2], S[i][8 * sI + 3]); w.z = pk2(S[i][8 * sI + 4], S[i][8 * sI + 5]); w.w = pk2(S[i][8 * sI + 6], S[i][8 * sI + 7]);
                            o = MFMA32(a, __builtin_bit_cast(bf16x8, w), o); }
#pragma unroll
                    for (int i = 0; i < 8; ++i) {
#pragma unroll
                        for (int st = 0; st < 2; ++st) { const bf16x8 a = *(const LAS bf16x8*)(sb + KTF_OFF + ((2 * i + st) * 64 + lane) * 16); S[i] = MFMA32(a, Vf[st], S[i]); }
#pragma unroll
                        for (int g = 0; g < 4; ++g) { const f32x4 d = *(const LAS f32x4*)(sb + C_DEC + (32 * i + 8 * g + 4 * hh) * 4);
                            S[i][4 * g] *= d[0]; S[i][4 * g + 1] *= d[1]; S[i][4 * g + 2] *= d[2]; S[i][4 * g + 3] *= d[3]; }
                        asm volatile("" : "+v"(S[i]));
                    }
                    char* ob = (char*)(Og + (size_t)(c * CHUNK + 4 * hh) * (NH * DVH) + 32 * wave + r);
#pragma unroll
                    for (int i = 0; i < 16; ++i) *(float*)(ob + (size_t)((i & 3) + 8 * (i >> 2)) * (NH * DVH * 4)) = o[i];
                }
                sl = sl == 2 ? 0 : sl + 1;
            }
            }
            if (wave < 4) {
                float* so = out + O_GP + (size_t)bh * DKH * DVH + 128 * half + 32 * wave + r + 4 * hh * DVH;
#pragma unroll
                for (int i = 0; i < 8; ++i) {
#pragma unroll
                    for (int e = 0; e < 16; ++e) so[(unsigned)((32 * i + (e & 3) + 8 * (e >> 2)) * DVH)] = S[i][e];
                    asm volatile("" ::: "memory"); }
            }
            VM_WAIT(); __syncthreads();
        } else {
#ifdef DUP3B
            for (int rep3_ = 0; rep3_ < 2; ++rep3_) {
#else
            {
#endif
            for (int it = (blockIdx.x - 2 * NBATCH * NH) * 512 + tid; it < MS * (DC / 8); it += (F.G - 2 * NBATCH * NH) * 512) {
            const int b = it >> 8, oct = it & 255, c = oct * 8, row = MP + b;
            f32x4 w0a = *(const f32x4*)(w_conv + c), w0b = *(const f32x4*)(w_conv + c + 4), w1a = *(const f32x4*)(w_conv + DC + c), w1b = *(const f32x4*)(w_conv + DC + c + 4),
                  w2a = *(const f32x4*)(w_conv + 2 * DC + c), w2b = *(const f32x4*)(w_conv + 2 * DC + c + 4);
            const float* sc = state_conv + (size_t)b * 2 * DC + c;
            const f32x4 um2a = *(const f32x4*)(sc), um2b = *(const f32x4*)(sc + 4), um1a = *(const f32x4*)(sc + DC), um1b = *(const f32x4*)(sc + DC + 4);
            const bf16* zr = Z + (size_t)row * NZ + c; f32x4 ha, hb, ca, cb, ba, bb;
            unpk8(*(const v4u*)(zr + ZH), ha, hb); unpk8(*(const v4u*)(zr + ZC), ca, cb); unpk8(*(const v4u*)(zr + ZB), ba, bb);
            const f32x4 ua = ha * ca, ub = hb * cb;
            const f32x4 oa = ba * (w0a * um2a + w1a * um1a + w2a * ua), ob = bb * (w0b * um2b + w1b * um1b + w2b * ub);
            *(v4u*)(A2 + (size_t)row * LD2 + c) = pk8(oa, ob);
            float* o0 = out + O_CS + (size_t)b * 2 * DC + c;
            *(f32x4*)(o0) = um1a; *(f32x4*)(o0 + 4) = um1b; *(f32x4*)(o0 + DC) = ua; *(f32x4*)(o0 + DC + 4) = ub;
        }
            LAS float* ws_ = (LAS float*)(F.lds + wave * 768);
            LAS float* part = (LAS float*)(F.lds + 8192);
            const int nbs = F.G - 2 * NBATCH * NH;
            for (int pr = blockIdx.x - 2 * NBATCH * NH; pr < MS * NH / 2; pr += nbs) {
                const int u = 2 * pr + (wave >> 2), b = u >> 3, h = u & 7, row = MP + b, kk0 = 64 * (wave & 3), kk = kk0 + lane;
                {
                    f32x4 al[4];
#pragma unroll
                    for (int q = 0; q < 4; ++q) { const float* ap = ALR + (size_t)row * 16 + 4 * q; al[q] = (*(const f32x4*)(ap) + *(const f32x4*)(ap + (size_t)MROWS * 16)) + (*(const f32x4*)(ap + (size_t)2 * MROWS * 16) + *(const f32x4*)(ap + (size_t)3 * MROWS * 16)); }
                    const f32x4 q4 = *(const f32x4*)(SSQ4 + 4 * (size_t)row); const float rs0 = 1.0f / sqrtf(((q4[0] + q4[1]) + (q4[2] + q4[3])) * (1.0f / DM) + EPS);
                    float x = 0.f;
#pragma unroll
                    for (int jj = 0; jj < 16; ++jj) x += al[jj >> 2][jj & 3] * w_alpha2[(size_t)jj * (NH * DKH) + h * 256 + kk];
                    x = x * rs0 + b_alpha[h * 256 + kk];
                    ws_[lane] = expf_fast(logsig(x) * (1.0f / 16.0f));
                    ws_[64 + lane] = __uint_as_float((unsigned)Z[(size_t)row * NZ + ZK + h * 256 + kk] << 16);
                    ws_[128 + lane] = __uint_as_float((unsigned)Z[(size_t)row * NZ + ZQ + h * 256 + kk] << 16) * 0.0625f;
                }
                LDS_WAIT(); asm volatile("" ::: "memory");
                f32x4 vv; { const v2u w = *(const v2u*)(Z + (size_t)row * NZ + ZV + h * 256 + 4 * lane); vv = (f32x4){bflo(w.x), bfhi(w.x), bflo(w.y), bfhi(w.y)}; }
                const float* s0 = state_gla + ((size_t)(b * NH + h) * DKH + kk0) * DVH + 4 * lane; float* s1 = out + O_GS + ((size_t)(b * NH + h) * DKH + kk0) * DVH + 4 * lane;
                f32x4 o = (f32x4){0.f, 0.f, 0.f, 0.f};
                f32x4 cbuf[16], nbuf[16];
#pragma unroll
                for (int i = 0; i < 16; ++i) cbuf[i] = *(const f32x4*)(s0 + (size_t)i * DVH);
#pragma unroll
                for (int k0 = 0; k0 < 64; k0 += 16) {
                    if (k0 + 16 < 64) {
#pragma unroll
                        for (int i = 0; i < 16; ++i) nbuf[i] = *(const f32x4*)(s0 + (size_t)(k0 + 16 + i) * DVH);
                    }
#pragma unroll
                    for (int i = 0; i < 16; ++i) { const float a = ws_[k0 + i], kf = ws_[64 + k0 + i], qf = ws_[128 + k0 + i];
                        const f32x4 sn = cbuf[i] * a + vv * kf; *(f32x4*)(s1 + (size_t)(k0 + i) * DVH) = sn; o += sn * qf; }
#pragma unroll
                    for (int i = 0; i < 16; ++i) cbuf[i] = nbuf[i];
                }
                *(LAS f32x4*)(part + wave * 256 + 4 * lane) = o;
                __syncthreads();
                if ((wave & 3) == 0) {
                    const LAS float* pp_ = part + wave * 256 + 4 * lane;
                    const f32x4 ot = (*(const LAS f32x4*)(pp_) + *(const LAS f32x4*)(pp_ + 256)) + (*(const LAS f32x4*)(pp_ + 512) + *(const LAS f32x4*)(pp_ + 768));
                    const float tot = wave_sum((ot[0] * ot[0] + ot[1] * ot[1]) + (ot[2] * ot[2] + ot[3] * ot[3]));
                    const float rstd = 1.0f / sqrtf(tot * (1.0f / DVH) + EPS);
                    const f32x4 gg = *(const f32x4*)(g_gla + 4 * lane);
                    const v2u rw = *(const v2u*)(Z + (size_t)row * NZ + ZR + h * 256 + 4 * lane);
                    v2u ow; ow.x = pk2(ot[0] * rstd * gg[0] * silu(bflo(rw.x)), ot[1] * rstd * gg[1] * silu(bfhi(rw.x))); ow.y = pk2(ot[2] * rstd * gg[2] * silu(bflo(rw.y)), ot[3] * rstd * gg[3] * silu(bfhi(rw.y)));
                    *(v2u*)(B2 + (size_t)row * LD2 + h * 256 + 4 * lane) = ow;
                }
                __syncthreads();
            }
            { const int sgw = ((int)blockIdx.x - 2 * NBATCH * NH) * NWAVES + wave, snw = (F.G - 2 * NBATCH * NH) * NWAVES;
          for (int n = sgw; n < DM; n += snw) { const bf16* wr_ = WOB + (size_t)n * LD2; f32x4 wv[8]; float am = 0.f;
#pragma unroll
              for (int ch = 0; ch < 8; ++ch) { const v2u w2 = *(const v2u*)(wr_ + 256 * ch + 4 * lane); f32x4 a = (f32x4){bflo(w2.x), bfhi(w2.x), bflo(w2.y), bfhi(w2.y)}; fwht32(a, lane); wv[ch] = a; }
#pragma unroll
              for (int st = 1; st < 8; st <<= 1)
#pragma unroll
                  for (int ch = 0; ch < 8; ++ch) if (!(ch & st)) { const f32x4 t = wv[ch] + wv[ch | st], u = wv[ch] - wv[ch | st]; wv[ch] = t; wv[ch | st] = u; }
#pragma unroll
              for (int ch = 0; ch < 8; ++ch) am = fmaxf(am, fmaxf(fmaxf(fabsf(wv[ch][0]), fabsf(wv[ch][1])), fmaxf(fabsf(wv[ch][2]), fabsf(wv[ch][3]))));
#pragma unroll
              for (int sh = 1; sh < 64; sh <<= 1) am = fmaxf(am, __shfl_xor(am, sh));
              am = fmaxf(am, 1e-30f); const float inv = 127.0f / am;
              if (lane == 0) ((float*)(ws + WS_SWB))[n] = am * (1.0f / 127.0f);
#pragma unroll
              for (int ch = 0; ch < 8; ++ch) { unsigned q_[4];
#pragma unroll
                  for (int e_ = 0; e_ < 4; ++e_) q_[e_] = __float_as_uint(fmaf(wv[ch][e_], inv, 12582912.0f));
                  *(unsigned*)(ws + WS_WOB8 + (size_t)n * LDB8 + 256 * ch + 4 * lane) = __builtin_amdgcn_perm(q_[1], q_[0], 0x0c0c0400u) | __builtin_amdgcn_perm(q_[3], q_[2], 0x04000c0cu); } }
        for (int n = sgw; n < DM; n += snw) { const float am = fmaxf(__uint_as_float(((const unsigned*)(ws + WS_WMAXP))[n]), 1e-30f);
            if (lane == 0) ((float*)(ws + WS_SWP))[n] = am * (1.0f / 127.0f);
            const float inv = 127.0f / am;
            QUANT_ROW(WPG + (size_t)n * LD4, ws + WS_WPGI + (size_t)n * LD8, inv); }
            }
            }
        }
        }
        if (BOTH(3)) GRID_BAR(3);
    }

    if (IN(4)) { REP(4) {
        PHASE_IDS;
        const float* g_gla = inptr(13);
        const float* Ob = (const float*)(ws + WS_O);
        const f32x4 gg = *(const f32x4*)(g_gla + 4 * lane);
        for (int it0 = gw * 8; it0 < MP * NH; it0 += NGW * 8) {
            f32x4 o[8]; v2u rw[8]; const int row = it0 >> 3;
#pragma unroll
            for (int q = 0; q < 8; ++q) { o[q] = *(const f32x4*)(Ob + (size_t)row * (NH * DVH) + q * DVH + 4 * lane); rw[q] = *(const v2u*)(Z + (size_t)row * NZ + ZR + q * 256 + 4 * lane); }
            float am = 0.f;
#pragma unroll
            for (int q = 0; q < 8; ++q) {
                const float tot = wave_sum((o[q][0] * o[q][0] + o[q][1] * o[q][1]) + (o[q][2] * o[q][2] + o[q][3] * o[q][3]));
                const float rstd = 1.0f / sqrtf(tot * (1.0f / DVH) + EPS) * (1.0f / 256.0f);
                f32x4 y = (f32x4){o[q][0] * rstd * gg[0] * silu(bflo(rw[q].x)), o[q][1] * rstd * gg[1] * silu(bfhi(rw[q].x)), o[q][2] * rstd * gg[2] * silu(bflo(rw[q].y)), o[q][3] * rstd * gg[3] * silu(bfhi(rw[q].y))};
                fwht32(y, lane); o[q] = y; }
#pragma unroll
            for (int st = 1; st < 8; st <<= 1)
#pragma unroll
                for (int q = 0; q < 8; ++q) if (!(q & st)) { const f32x4 t = o[q] + o[q | st], u = o[q] - o[q | st]; o[q] = t; o[q | st] = u; }
#pragma unroll
            for (int q = 0; q < 8; ++q) am = fmaxf(am, fmaxf(fmaxf(fabsf(o[q][0]), fabsf(o[q][1])), fmaxf(fabsf(o[q][2]), fabsf(o[q][3]))));
#pragma unroll
            for (int sh = 1; sh < 64; sh <<= 1) am = fmaxf(am, __shfl_xor(am, sh));
            am = fmaxf(am, 1e-30f); const float inv = 127.0f / am;
            if (lane == 0) ((float*)(ws + WS_RS2))[row] = am * (1.0f / 127.0f);
#pragma unroll
            for (int q = 0; q < 8; ++q) { unsigned q_[4];
#pragma unroll
                for (int e_ = 0; e_ < 4; ++e_) q_[e_] = __float_as_uint(fmaf(o[q][e_], inv, 12582912.0f));
                *(unsigned*)(ws + WS_B8 + (size_t)row * LDB8 + q * 256 + 4 * lane) = __builtin_amdgcn_perm(q_[1], q_[0], 0x0c0c0400u) | __builtin_amdgcn_perm(q_[3], q_[2], 0x04000c0cu); }
        }
        }
        if (BOTH(4)) GRID_BAR(4);
    }

    if (IN(5)) { REP(5) {
        pg8::StaticOrder S; S.init(MP, DM, F.G, (int)blockIdx.x);
        pg8::Gemm ga{A2, WOA, MPAD, DM, DC, LD2}, gb{B2, WOB, MPAD, DM, DC, LD2};
        { pg8::EpiGate1 E{Z + ZGA, NZ, MRG, LD4, 2}; pg8::gemm_phase<pg8::EpiGate1, pg8::StaticOrder, true, true>(F.lds + RING_OFF, ga, S, E); }
        { pg8::Gemm gb8{(const bf16*)(ws + WS_B8), (const bf16*)(ws + WS_WOB8), MPAD, DM, DC / 2, LDB8 / 2};
          pg8::EpiGate2 E{Z + ZGB, NZ, MRG, LD4, 2, (const float*)(ws + WS_RS2), (const float*)(ws + WS_SWB)}; pg8::gemm_phase<pg8::EpiGate2, pg8::StaticOrder, true, true, false, false, true>(F.lds + RING_OFF, gb8, S, E); }
        { pg8::Gemm gs{A2, WOA, MPAD, DM, 256, LD2}; pg8::SplitOrder S2{MP / 256, DM / 256, 8, 0, 0, 256, 0, (DM / 256) * (8), (int)blockIdx.x, 0}; pg8::EpiF32 E{(float*)(ws + WS_PS4), DM, 1, 128};
          pg8::gemm_phase<pg8::EpiF32, pg8::SplitOrder, true, true, true>(F.lds + RING_OFF, gs, S2, E); }
        { pg8::Gemm gs{B2, WOB, MPAD, DM, 256, LD2}; pg8::SplitOrder S2{MP / 256, DM / 256, 8, 0, 0, 256, 128, (DM / 256) * (8), (int)blockIdx.x, 0}; pg8::EpiF32 E{(float*)(ws + WS_PS4) + (size_t)8 * 128 * DM, DM, 1, 128};
          pg8::gemm_phase<pg8::EpiF32, pg8::SplitOrder, true, true, true>(F.lds + RING_OFF, gs, S2, E); }
        }
        if (BOTH(5)) GRID_BAR(5);
    }

    if (IN(6)) { REP(6) {
        PHASE_IDS;
        const float* PA = (const float*)(ws + WS_PS4); const float* PB = PA + (size_t)8 * 128 * DM;
        for (int it = gw; it < MS * 8; it += NGW) { const int r = it >> 3, col = (it & 7) * 512 + lane * 8, row = MP + r;
            f32x4 a0 = (f32x4){0.f, 0.f, 0.f, 0.f}, a1 = a0, b0 = a0, b1 = a0;
#pragma unroll
            for (int sp = 0; sp < 8; ++sp) { const size_t o = ((size_t)sp * 128 + r) * DM + col;
                a0 += *(const f32x4*)(PA + o); a1 += *(const f32x4*)(PA + o + 4); b0 += *(const f32x4*)(PB + o); b1 += *(const f32x4*)(PB + o + 4); }
            f32x4 ga0, ga1, gb0, gb1; unpk8(*(const v4u*)(Z + (size_t)row * NZ + ZGA + col), ga0, ga1); unpk8(*(const v4u*)(Z + (size_t)row * NZ + ZGB + col), gb0, gb1);
            f32x4 m0, m1;
#pragma unroll
            for (int q = 0; q < 4; ++q) { m0[q] = sigm(ga0[q]) * a0[q] + sigm(gb0[q]) * b0[q]; m1[q] = sigm(ga1[q]) * a1[q] + sigm(gb1[q]) * b1[q]; }
            *(v4u*)(MRG + (size_t)row * LD4 + col) = pk8(m0, m1); }
        }
        if (BOTH(6)) GRID_BAR(6);
    }

    if (IN(7)) { REP(7) {
        const float* x_prompt = inptr(0); const float* x_sample = inptr(1);
        pg8::Gemm g{MRG, WMIX, MPAD, DM, DM, LD4};
        { pg8::StaticOrder S; S.init(MP, DM, F.G, (int)blockIdx.x); pg8::EpiRes<0> E{x_prompt, x_sample, out + O_Y, XN, LD4, PART, 2, nullptr, (float*)(ws + WS_PARTM), nullptr, nullptr};
          pg8::gemm_phase<pg8::EpiRes<0>, pg8::StaticOrder, true, true>(F.lds + RING_OFF, g, S, E); }
        { pg8::Gemm gs{MRG, WMIX, MPAD, DM, 256, LD4}; pg8::SplitOrder S2{MP / 256, DM / 256, 16, 0, 0, 256, 0, (DM / 256) * (16), (int)blockIdx.x, 0}; pg8::EpiF32 E{(float*)(ws + WS_PS6), DM, 1, 128};
          pg8::gemm_phase<pg8::EpiF32, pg8::SplitOrder, true, true, true>(F.lds + RING_OFF, gs, S2, E); }
        }
        if (BOTH(7)) GRID_BAR(7);
    }
    if (IN(8)) { REP(8) {
        PHASE_IDS;
        const float* x_sample = inptr(1);
        float* RS2 = (float*)(ws + WS_RS2); float* SW = (float*)(ws + WS_SW); const float* PARTM = (const float*)(ws + WS_PARTM);
        for (int row = gw; row < MPAD; row += NGW) {
            if (row < MP) { const float s = wave_sum(PART[(size_t)row * 64 + lane]); float am = PARTM[(size_t)row * 64 + lane];
#pragma unroll
                for (int o = 1; o < 64; o <<= 1) am = fmaxf(am, __shfl_xor(am, o));
                am = fmaxf(am, 1e-30f); const float rstd = 1.0f / sqrtf(s * (1.0f / DM) + EPS);
                if (lane == 0) { RSTD[row] = rstd; RS2[row] = rstd * am * (1.0f / 127.0f); }
                const float inv = 127.0f / am;
                QUANT_ROW(XN + (size_t)row * LD4, ws + WS_H1Q + (size_t)row * LD8, inv);
                const int t = row & (TSEQ - 1);
                if (t >= TSEQ - 2) { bf16* dp = XN + (size_t)(MROWS + 2 * (row / TSEQ) + (t - (TSEQ - 2))) * LD4; const bf16* sp = XN + (size_t)row * LD4;
#pragma unroll
                    for (int j = 0; j < 8; ++j) *(v4u*)(dp + 512 * j + 8 * lane) = *(const v4u*)(sp + 512 * j + 8 * lane); } }
            else if (row >= MROWS) { if (lane == 0) RSTD[row] = 0.f; }
        }
        for (int n = gw; n < NUP; n += NGW) { const float am = fmaxf(__uint_as_float(((const unsigned*)(ws + WS_WMAX))[n]), 1e-30f);
            if (lane == 0) SW[n] = am * (1.0f / 127.0f);
            const float inv = 127.0f / am;
            QUANT_ROW(WUP + (size_t)n * LD4, ws + WS_WU8 + (size_t)n * LD8, inv); }
        for (int n = gw; n < DM; n += NGW) { const bf16* wr_ = WDN + (size_t)n * LDF; float am = 0.f;
            v4u raw[22];
#pragma unroll
            for (int bp = 0; bp < 22; ++bp) { const int k0 = 512 * bp + 8 * lane; raw[bp] = (v4u){0u, 0u, 0u, 0u}; if (k0 < DFF) raw[bp] = *(const v4u*)(wr_ + k0); }
#pragma unroll
            for (int bp = 0; bp < 22; ++bp) { f32x4 a, b; unpk8(raw[bp], a, b); fwht64(a, b, lane);
                am = fmaxf(am, fmaxf(fmaxf(fmaxf(fabsf(a[0]), fabsf(a[1])), fmaxf(fabsf(a[2]), fabsf(a[3]))), fmaxf(fmaxf(fabsf(b[0]), fabsf(b[1])), fmaxf(fabsf(b[2]), fabsf(b[3]))))); }
#pragma unroll
            for (int o = 1; o < 64; o <<= 1) am = fmaxf(am, __shfl_xor(am, o));
            am = fmaxf(am, 1e-30f);
            if (lane == 0) ((float*)(ws + WS_SWD))[n] = am * (1.0f / 127.0f);
            const float inv = 127.0f / am; unsigned char* q8 = ws + WS_WD8 + (size_t)n * LDA8;
#pragma unroll
            for (int bp = 0; bp < 22; ++bp) { const int k0 = 512 * bp + 8 * lane; f32x4 a, b; unpk8(raw[bp], a, b); fwht64(a, b, lane);
                unsigned q_[8];
#pragma unroll
                for (int e_ = 0; e_ < 4; ++e_) { q_[e_] = __float_as_uint(fmaf(a[e_], inv, 12582912.0f)); q_[4 + e_] = __float_as_uint(fmaf(b[e_], inv, 12582912.0f)); }
                v2u o_; o_.x = __builtin_amdgcn_perm(q_[1], q_[0], 0x0c0c0400u) | __builtin_amdgcn_perm(q_[3], q_[2], 0x04000c0cu); o_.y = __builtin_amdgcn_perm(q_[5], q_[4], 0x0c0c0400u) | __builtin_amdgcn_perm(q_[7], q_[6], 0x04000c0cu);
                if (k0 < DFF) *(v2u*)(q8 + k0) = o_; } }
        { LAS float* red = (LAS float*)(F.lds);
          for (int r = blockIdx.x; r < MS; r += F.G) { const int row = MP + r; const float* PS = (const float*)(ws + WS_PS6) + (size_t)r * DM; float ss = 0.f;
#pragma unroll
              for (int j2 = 0; j2 < 2; ++j2) { const int col = 512 * wave + 256 * j2 + 4 * lane; f32x4 h = *(const f32x4*)(x_sample + (size_t)r * DM + col);
#pragma unroll
                  for (int sp = 0; sp < 16; ++sp) h += *(const f32x4*)(PS + (size_t)sp * 128 * DM + col);
                  ss += (h[0] * h[0] + h[1] * h[1]) + (h[2] * h[2] + h[3] * h[3]);
                  *(f32x4*)(out + O_Y + (size_t)row * DM + col) = h;
                  v2u o; o.x = pk2(h[0], h[1]); o.y = pk2(h[2], h[3]); *(v2u*)(XN + (size_t)row * LD4 + col) = o; }
              ss = wave_sum(ss); if (lane == 0) red[wave] = ss; __syncthreads();
              if (tid == 0) { const float tot = ((red[0] + red[1]) + (red[2] + red[3])) + ((red[4] + red[5]) + (red[6] + red[7])); RSTD[row] = 1.0f / sqrtf(tot * (1.0f / DM) + EPS); }
              __syncthreads(); } }
        }
        if (BOTH(8)) GRID_BAR(8);
    }
    if (IN(9)) { REP(9) {
        pg8::Gemm g{(const bf16*)(ws + WS_H1Q), (const bf16*)(ws + WS_WU8), MPAD, NUP, DM / 2, LD8 / 2};
        { pg8::StaticOrder S; S.init(MP, NUP, F.G, (int)blockIdx.x); pg8::EpiBfI8 E{UP, NUP, (const float*)(ws + WS_RS2), (const float*)(ws + WS_SW), 2};
          pg8::gemm_phase<pg8::EpiBfI8, pg8::StaticOrder, true, true, false, false, true>(F.lds + RING_OFF, g, S, E); }
        { pg8::Gemm gs{XN, WUP, MPAD, NUP, 1024, LD4}; pg8::SplitOrder S2{MP / 256, NUP / 256, 4, 0, 0, 1024, 0, F.G, (int)blockIdx.x, (F.G == 256) ? 2 : 0}; pg8::EpiF32S E{(float*)(ws + WS_PS9), NUP};
          pg8::gemm_phase<pg8::EpiF32S, pg8::SplitOrder, true, true, false>(F.lds + RING_OFF, gs, S2, E); }
        }
        if (BOTH(9)) GRID_BAR(9);
    }
    if (IN(10)) { REP(10) {
        PHASE_IDS;
        const float* w_ffn_conv = inptr(18); const float* state_ffn = inptr(6);
        constexpr int NOCT = DFF / 8;
        for (int rb = blockIdx.x; rb < MP / 32; rb += F.G) {
            const int r0 = rb * 32, t0 = r0 & (TSEQ - 1);
            LAS unsigned* rowmax = (LAS unsigned*)(F.lds);
            __syncthreads(); if (tid < 32) rowmax[tid] = 0u; __syncthreads();
            const int rot = 32 * ((rb * 5) % 43);
            for (int oct0 = tid; oct0 < NOCT; oct0 += 512) {
                int oct = oct0 + rot; if (oct >= NOCT) oct -= NOCT;
                const int c = oct * 8;
                f32x4 wg[3][2], wv[3][2];
#pragma unroll
                for (int j = 0; j < 3; ++j) { wg[j][0] = *(const f32x4*)(w_ffn_conv + (size_t)j * NUP + c); wg[j][1] = *(const f32x4*)(w_ffn_conv + (size_t)j * NUP + c + 4);
                    wv[j][0] = *(const f32x4*)(w_ffn_conv + (size_t)j * NUP + DFF + c); wv[j][1] = *(const f32x4*)(w_ffn_conv + (size_t)j * NUP + DFF + c + 4); }
                f32x4 g2a = (f32x4){0.f, 0.f, 0.f, 0.f}, g2b = g2a, g1a = g2a, g1b = g2a, v2a = g2a, v2b = g2a, v1a = g2a, v1b = g2a;
                const bf16* ub = UP + (size_t)r0 * NUP + c;
                v4u lg[2][4], lv[2][4];
#pragma unroll
                for (int i = 0; i < 4; ++i) { lg[0][i] = *(const v4u*)(ub + (size_t)i * NUP); lv[0][i] = *(const v4u*)(ub + (size_t)i * NUP + DFF); }
                if (t0 != 0) { const bf16* ur = ub - 2 * (size_t)NUP;
                    unpk8(*(const v4u*)(ur), g2a, g2b); unpk8(*(const v4u*)(ur + DFF), v2a, v2b); unpk8(*(const v4u*)(ur + NUP), g1a, g1b); unpk8(*(const v4u*)(ur + NUP + DFF), v1a, v1b); }
#pragma unroll
                for (int k = 0; k < 8; ++k) {
                    if (k + 1 < 8) {
#pragma unroll
                        for (int i = 0; i < 4; ++i) { lg[(k + 1) & 1][i] = *(const v4u*)(ub + (size_t)(4 * (k + 1) + i) * NUP); lv[(k + 1) & 1][i] = *(const v4u*)(ub + (size_t)(4 * (k + 1) + i) * NUP + DFF); }
                    }
#pragma unroll
                    for (int i = 0; i < 4; ++i) { f32x4 ga, gb, va, vb;
                        unpk8(lg[k & 1][i], ga, gb); unpk8(lv[k & 1][i], va, vb);
                        const f32x4 cga = wg[0][0] * g2a + wg[1][0] * g1a + wg[2][0] * ga, cgb = wg[0][1] * g2b + wg[1][1] * g1b + wg[2][1] * gb;
                        const f32x4 cva = wv[0][0] * v2a + wv[1][0] * v1a + wv[2][0] * va, cvb = wv[0][1] * v2b + wv[1][1] * v1b + wv[2][1] * vb;
                        f32x4 oa, ob;
#pragma unroll
                        for (int q = 0; q < 4; ++q) { oa[q] = silu(cga[q]) * cva[q]; ob[q] = silu(cgb[q]) * cvb[q]; }
                        fwht64(oa, ob, lane);
                        oa = oa * 0.015625f; ob = ob * 0.015625f;
                        *(v4u*)(UPA + (size_t)(r0 + 4 * k + i) * LDF + c) = pk8(oa, ob);
                        { float mx = fmaxf(fmaxf(fmaxf(fabsf(oa[0]), fabsf(oa[1])), fmaxf(fabsf(oa[2]), fabsf(oa[3]))), fmaxf(fmaxf(fabsf(ob[0]), fabsf(ob[1])), fmaxf(fabsf(ob[2]), fabsf(ob[3]))));
                          mx = fmaxf(mx, __int_as_float(__builtin_amdgcn_mov_dpp(__float_as_int(mx), 0xB1, 0xf, 0xf, true))); mx = fmaxf(mx, __int_as_float(__builtin_amdgcn_mov_dpp(__float_as_int(mx), 0x4E, 0xf, 0xf, true)));
                          mx = fmaxf(mx, __int_as_float(__builtin_amdgcn_mov_dpp(__float_as_int(mx), 0x124, 0xf, 0xf, true))); mx = fmaxf(mx, __int_as_float(__builtin_amdgcn_mov_dpp(__float_as_int(mx), 0x128, 0xf, 0xf, true)));
                          if ((lane & 15) == 0) __hip_atomic_fetch_max(rowmax + 4 * k + i, __float_as_uint(mx), __ATOMIC_RELAXED, __HIP_MEMORY_SCOPE_WORKGROUP); }
                        g2a = g1a; g2b = g1b; g1a = ga; g1b = gb; v2a = v1a; v2b = v1b; v1a = va; v1b = vb; }
                }
                if (t0 + 32 == TSEQ) { const int b = r0 / TSEQ;
#pragma unroll
                    for (int j = 0; j < 2; ++j) { f32x4 ga = (f32x4){0.f, 0.f, 0.f, 0.f}, gb = ga, va = ga, vb = ga; const float rsr = RSTD[r0 + 30 + j];
#pragma unroll
                        for (int sp = 0; sp < 4; ++sp) { const float* p = (const float*)(ws + WS_PS9) + ((size_t)sp * 144 + 128 + 2 * b + j) * NUP + c; ga += *(const f32x4*)p; gb += *(const f32x4*)(p + 4); va += *(const f32x4*)(p + DFF); vb += *(const f32x4*)(p + DFF + 4); }
                        float* o0 = out + O_FP + ((size_t)b * 2 + j) * NUP + c;
                        *(f32x4*)(o0) = ga * rsr; *(f32x4*)(o0 + 4) = gb * rsr; *(f32x4*)(o0 + DFF) = va * rsr; *(f32x4*)(o0 + DFF + 4) = vb * rsr; } }
            }
            VM_WAIT(); __syncthreads();
            if (tid < 32) ((float*)(ws + WS_RS2))[r0 + tid] = fmaxf(__uint_as_float(rowmax[tid]) * 1.004f, 1e-30f) * (1.0f / 127.0f);
            for (int oct0 = tid; oct0 < NOCT; oct0 += 512) {
                int oct = oct0 + rot; if (oct >= NOCT) oct -= NOCT;
                const int c = oct * 8;
#pragma unroll 1
                for (int i0 = 0; i0 < 32; i0 += 8) { v4u w8[8];
#pragma unroll
                    for (int i = 0; i < 8; ++i) w8[i] = *(const v4u*)(UPA + (size_t)(r0 + i0 + i) * LDF + c);
#pragma unroll
                    for (int i = 0; i < 8; ++i) { const float inv = 127.0f / fmaxf(__uint_as_float(rowmax[i0 + i]) * 1.004f, 1e-30f); f32x4 a, b; unpk8(w8[i], a, b); unsigned q_[8];
#pragma unroll
                        for (int e_ = 0; e_ < 4; ++e_) { q_[e_] = __float_as_uint(fmaf(a[e_], inv, 12582912.0f)); q_[4 + e_] = __float_as_uint(fmaf(b[e_], inv, 12582912.0f)); }
                        v2u o_; o_.x = __builtin_amdgcn_perm(q_[1], q_[0], 0x0c0c0400u) | __builtin_amdgcn_perm(q_[3], q_[2], 0x04000c0cu); o_.y = __builtin_amdgcn_perm(q_[5], q_[4], 0x0c0c0400u) | __builtin_amdgcn_perm(q_[7], q_[6], 0x04000c0cu);
                        *(v2u*)(ws + WS_A8 + (size_t)(r0 + i0 + i) * LDA8 + c) = o_; } }
            }
        }
        for (int it = blockIdx.x * 512 + tid; it < MS * NOCT; it += F.G * 512) {
            const int b = it / NOCT, oct = it - b * NOCT, c = oct * 8, row = MP + b;
            f32x4 wg[3][2], wv[3][2];
#pragma unroll
            for (int j = 0; j < 3; ++j) { wg[j][0] = *(const f32x4*)(w_ffn_conv + (size_t)j * NUP + c); wg[j][1] = *(const f32x4*)(w_ffn_conv + (size_t)j * NUP + c + 4);
                wv[j][0] = *(const f32x4*)(w_ffn_conv + (size_t)j * NUP + DFF + c); wv[j][1] = *(const f32x4*)(w_ffn_conv + (size_t)j * NUP + DFF + c + 4); }
            const float* sf = state_ffn + (size_t)b * 2 * NUP + c;
            const f32x4 g2a = *(const f32x4*)(sf), g2b = *(const f32x4*)(sf + 4), v2a = *(const f32x4*)(sf + DFF), v2b = *(const f32x4*)(sf + DFF + 4);
            const f32x4 g1a = *(const f32x4*)(sf + NUP), g1b = *(const f32x4*)(sf + NUP + 4), v1a = *(const f32x4*)(sf + NUP + DFF), v1b = *(const f32x4*)(sf + NUP + DFF + 4);
            f32x4 ga = (f32x4){0.f, 0.f, 0.f, 0.f}, gb = ga, va = ga, vb = ga; const float rsr = RSTD[row];
#pragma unroll
            for (int sp = 0; sp < 4; ++sp) { const float* p = (const float*)(ws + WS_PS9) + ((size_t)sp * 144 + b) * NUP + c; ga += *(const f32x4*)p; gb += *(const f32x4*)(p + 4); va += *(const f32x4*)(p + DFF); vb += *(const f32x4*)(p + DFF + 4); }
            ga = ga * rsr; gb = gb * rsr; va = va * rsr; vb = vb * rsr;
            const f32x4 cga = wg[0][0] * g2a + wg[1][0] * g1a + wg[2][0] * ga, cgb = wg[0][1] * g2b + wg[1][1] * g1b + wg[2][1] * gb;
            const f32x4 cva = wv[0][0] * v2a + wv[1][0] * v1a + wv[2][0] * va, cvb = wv[0][1] * v2b + wv[1][1] * v1b + wv[2][1] * vb;
            f32x4 oa, ob;
#pragma unroll
            for (int q = 0; q < 4; ++q) { oa[q] = silu(cga[q]) * cva[q]; ob[q] = silu(cgb[q]) * cvb[q]; }
            *(v4u*)(UPA + (size_t)row * LDF + c) = pk8(oa, ob);
            float* o0 = out + O_FS + (size_t)b * 2 * NUP + c;
            *(f32x4*)(o0) = g1a; *(f32x4*)(o0 + 4) = g1b; *(f32x4*)(o0 + DFF) = v1a; *(f32x4*)(o0 + DFF + 4) = v1b;
            *(f32x4*)(o0 + NUP) = ga; *(f32x4*)(o0 + NUP + 4) = gb; *(f32x4*)(o0 + NUP + DFF) = va; *(f32x4*)(o0 + NUP + DFF + 4) = vb;
        }
        }
        if (BOTH(10)) GRID_BAR(10);
    }
    if (IN(11)) { REP(11) {
        const int c = (int)blockIdx.x, nsd = DM / 256;
        pg8::Gemm gd{UPA, WDN, MPAD, DM, DFF, LDF}, gp{PBF, WPP, MPAD, DM, PLE, LDP};
        { pg8::StaticOrder S; S.init(MP, DM, F.G, c); pg8::EpiRes<1> E{nullptr, nullptr, out + O_Y, XN, LD4, PART, 2, nullptr, (float*)(ws + WS_PARTM), (const float*)(ws + WS_RS2), (const float*)(ws + WS_SWD)};
          pg8::Gemm gd8{(const bf16*)(ws + WS_A8), (const bf16*)(ws + WS_WD8), MPAD, DM, DFF / 2, LDA8 / 2};
          pg8::gemm_phase<pg8::EpiRes<1>, pg8::StaticOrder, true, true, false, false, true>(F.lds + RING_OFF, gd8, S, E); }
        { pg8::Gemm gs{UPA, WDN, MPAD, DM, 640, LDF}; pg8::SplitOrder S2{MP / 256, nsd, 10, 0, 0, 640, 0, (nsd) * (10), c, 0}; pg8::EpiF32 E{(float*)(ws + WS_PS10), DM, 1, 128};
          pg8::gemm_phase<pg8::EpiF32, pg8::SplitOrder, true, true, true>(F.lds + RING_OFF, gs, S2, E); }
        { pg8::Gemm gs{UPA, WDN, MPAD, DM, 768, LDF}; pg8::SplitOrder S2{MP / 256, nsd, 6, 10, 6400, 768, 160, (nsd) * (6), c, 0}; pg8::EpiF32 E{(float*)(ws + WS_PS10), DM, 1, 128};
          pg8::gemm_phase<pg8::EpiF32, pg8::SplitOrder, true, true, true>(F.lds + RING_OFF, gs, S2, E); }
        { pg8::StaticOrder S; S.init(MP, DM, F.G, c); pg8::EpiBf E{PP, DM, nullptr, 2, nullptr};
          pg8::gemm_phase<pg8::EpiBf, pg8::StaticOrder, true, true>(F.lds + RING_OFF, gp, S, E); }
        { pg8::PanelOrder S{MP / 256, nsd, 0, F.G, c}; pg8::EpiBf E{PP, DM, nullptr, 1, nullptr};
          pg8::gemm_phase<pg8::EpiBf, pg8::PanelOrder, true, true, true>(F.lds + RING_OFF, gp, S, E); }
        }
        if (BOTH(11)) GRID_BAR(11);
    }
    if (IN(12)) { REP(12) {
        PHASE_IDS;
        float* RS3 = (float*)(ws + WS_RS2); const float* PARTM = (const float*)(ws + WS_PARTM);
        for (int row = gw; row < MPAD; row += NGW) {
            if (row < MP) { const float s = wave_sum(PART[(size_t)row * 64 + lane]); float am = PARTM[(size_t)row * 64 + lane];
#pragma unroll
                for (int o = 1; o < 64; o <<= 1) am = fmaxf(am, __shfl_xor(am, o));
                am = fmaxf(am, 1e-30f); const float rstd = 1.0f / sqrtf(s * (1.0f / DM) + EPS);
                if (lane == 0) { RSTD[row] = rstd; RS3[row] = rstd * am * (1.0f / 127.0f); }
                const float inv = 127.0f / am;
                QUANT_ROW(XN + (size_t)row * LD4, ws + WS_H8 + (size_t)row * LD8, inv); }
            else if (row >= MROWS) { if (lane == 0) RSTD[row] = 0.f; }
        }
        { LAS float* red = (LAS float*)(F.lds);
          for (int r = blockIdx.x; r < MS; r += F.G) { const int row = MP + r; const float* PS = (const float*)(ws + WS_PS10) + (size_t)r * DM; float ss = 0.f;
#pragma unroll
              for (int j2 = 0; j2 < 2; ++j2) { const int col = 512 * wave + 256 * j2 + 4 * lane; float* op = out + O_Y + (size_t)row * DM + col; f32x4 h = *(const f32x4*)op;
#pragma unroll
                  for (int sp = 0; sp < 16; ++sp) h += *(const f32x4*)(PS + (size_t)sp * 128 * DM + col);
                  ss += (h[0] * h[0] + h[1] * h[1]) + (h[2] * h[2] + h[3] * h[3]);
                  *(f32x4*)op = h;
                  v2u o; o.x = pk2(h[0], h[1]); o.y = pk2(h[2], h[3]); *(v2u*)(XN + (size_t)row * LD4 + col) = o; }
              ss = wave_sum(ss); if (lane == 0) red[wave] = ss; __syncthreads();
              if (tid == 0) { const float tot = ((red[0] + red[1]) + (red[2] + red[3])) + ((red[4] + red[5]) + (red[6] + red[7])); RSTD[row] = 1.0f / sqrtf(tot * (1.0f / DM) + EPS); }
              __syncthreads(); } }
        }
        if (BOTH(12)) GRID_BAR(12);
    }
    if (IN(13)) { REP(13) {
        pg8::Gemm g{(const bf16*)(ws + WS_H8), (const bf16*)(ws + WS_WPGI), MPAD, DM, DM / 2, LD8 / 2};
        { pg8::StaticOrder S; S.init(MP, DM, F.G, (int)blockIdx.x); pg8::EpiPle E{(bf16*)(ws + WS_H3B), PP, (const float*)(ws + WS_RS2), PART, 2, XN, LD4, (const float*)(ws + WS_SWP)};
          pg8::gemm_phase<pg8::EpiPle, pg8::StaticOrder, true, true, false, false, true>(F.lds + RING_OFF, g, S, E); }
        { pg8::Gemm gs{XN, WPG, MPAD, DM, 256, LD4}; pg8::SplitOrder S2{MP / 256, DM / 256, 16, 0, 0, 256, 0, (DM / 256) * (16), (int)blockIdx.x, 0}; pg8::EpiF32 E{(float*)(ws + WS_PS12), DM, 1, 128};
          pg8::gemm_phase<pg8::EpiF32, pg8::SplitOrder, true, true, true>(F.lds + RING_OFF, gs, S2, E); }
        }
        if (BOTH(13)) GRID_BAR(13);
    }
    if (IN(14)) {
        PHASE_IDS;
        const float* g_final = inptr(23);
        for (int row = gw; row < MP; row += NGW) {
            float* yr = out + O_Y + (size_t)row * DM + 4 * lane;
            const float s = wave_sum(PART[(size_t)row * 64 + lane]); const float rstd = 1.0f / sqrtf(s * (1.0f / DM) + EPS);
            const bf16* hr = (const bf16*)(ws + WS_H3B) + (size_t)row * DM + 4 * lane;
            v2u hw[16];
#pragma unroll
            for (int j = 0; j < 16; ++j) hw[j] = *(const v2u*)(hr + 256 * j);
#pragma unroll
            for (int j = 0; j < 16; ++j) { const f32x4 g = *(const f32x4*)(g_final + 4 * lane + 256 * j);
                *(f32x4*)(yr + 256 * j) = (f32x4){bflo(hw[j].x), bfhi(hw[j].x), bflo(hw[j].y), bfhi(hw[j].y)} * rstd * g; }
        }
        { LAS float* red = (LAS float*)(F.lds);
          for (int r = blockIdx.x; r < MS; r += F.G) { const int row = MP + r; const float* PS = (const float*)(ws + WS_PS12) + (size_t)r * DM; const float rs2 = RSTD[row];
              f32x4 h[2]; float ss = 0.f;
#pragma unroll
              for (int j2 = 0; j2 < 2; ++j2) { const int col = 512 * wave + 256 * j2 + 4 * lane; f32x4 a = (f32x4){0.f, 0.f, 0.f, 0.f};
#pragma unroll
                  for (int sp = 0; sp < 16; ++sp) a += *(const f32x4*)(PS + (size_t)sp * 128 * DM + col);
                  f32x4 p; { const v2u pw = *(const v2u*)(PP + (size_t)row * DM + col); p = (f32x4){bflo(pw.x), bfhi(pw.x), bflo(pw.y), bfhi(pw.y)}; }
                  f32x4 hv = *(const f32x4*)(out + O_Y + (size_t)row * DM + col);
#pragma unroll
                  for (int q = 0; q < 4; ++q) hv[q] += sigm(a[q] * rs2) * p[q];
                  h[j2] = hv; ss += (hv[0] * hv[0] + hv[1] * hv[1]) + (hv[2] * hv[2] + hv[3] * hv[3]); }
              ss = wave_sum(ss); if (lane == 0) red[wave] = ss; __syncthreads();
              const float tot = ((red[0] + red[1]) + (red[2] + red[3])) + ((red[4] + red[5]) + (red[6] + red[7])); const float rstd = 1.0f / sqrtf(tot * (1.0f / DM) + EPS);
#pragma unroll
              for (int j2 = 0; j2 < 2; ++j2) { const int col = 512 * wave + 256 * j2 + 4 * lane; const f32x4 g = *(const f32x4*)(g_final + col); *(f32x4*)(out + O_Y + (size_t)row * DM + col) = h[j2] * rstd * g; }
              __syncthreads(); } }
    }
#undef IN
#undef BOTH
}

extern "C" void kernel_launch(void* const* d_in, const int* in_sizes, int n_in, void* d_out, int out_size, void* d_ws, size_t ws_size, hipStream_t stream) {
    static int grid = 0;
    if (grid == 0) {
        if (n_in != 24 || (size_t)out_size != O_END || ws_size < WS_END) { fprintf(stderr, "kernel_launch: unexpected sizes n_in %d out %d ws %zu\n", n_in, out_size, ws_size); grid = -1; return; }
        int dev = 0, cus = 0, per_cu = 0;
        if (hipGetDevice(&dev) != hipSuccess || hipDeviceGetAttribute(&cus, hipDeviceAttributeMultiprocessorCount, dev) != hipSuccess) { grid = -1; return; }
        if (hipFuncSetAttribute((const void*)mega_fwd, hipFuncAttributeMaxDynamicSharedMemorySize, LDS_BYTES) != hipSuccess) { fprintf(stderr, "kernel_launch: hipFuncSetAttribute failed\n"); grid = -1; return; }
        if (hipOccupancyMaxActiveBlocksPerMultiprocessor(&per_cu, (const void*)mega_fwd, NWAVES * 64, LDS_BYTES) != hipSuccess || per_cu < 1) { fprintf(stderr, "kernel_launch: occupancy query says %d blocks per CU\n", per_cu); (void)hipGetLastError(); grid = -1; return; }
        grid = cus;
    }
    if (grid < 0) return;
    if (hipMemsetAsync((char*)d_ws + WS_CTL, 0, CTL_ZERO_BYTES, stream) != hipSuccess) return;
    Args a{};
    for (int i = 0; i < 24; ++i) a.in[i] = (const float*)d_in[i];
    a.out = (float*)d_out; a.ws = (unsigned char*)d_ws;
    if (N_LAUNCHES == 1) { a.ph_lo = 0; a.ph_hi = NPHASE; hipLaunchKernelGGL(mega_fwd, dim3(grid), dim3(NWAVES * 64), LDS_BYTES, stream, a); }
    else for (int li = 0; li < NPHASE; ++li) { a.ph_lo = li; a.ph_hi = li + 1; hipLaunchKernelGGL(mega_fwd, dim3(grid), dim3(NWAVES * 64), LDS_BYTES, stream, a); }
}
```
